# Optimizing an MI355X kernel written in HIP

```python
import math
import jax, jax.numpy as jnp
from jax import lax
import numpy as np

D_MODEL = 2048
BATCH = 16
SEQ = 2048
DEPTH = 2

HEAD_DIM = 128
N_HEADS = D_MODEL // HEAD_DIM
MIX_WIDTH = N_HEADS * HEAD_DIM
A_HEADS = N_HEADS // 2
A_KV_HEADS = max(1, A_HEADS // 4)
A_GROUP = A_HEADS // A_KV_HEADS
A_Q = A_HEADS * HEAD_DIM
A_KV = A_KV_HEADS * HEAD_DIM
B_HEADS = N_HEADS - A_HEADS
B_QK_DIM = HEAD_DIM // 2
B_V_DIM = HEAD_DIM
B_QK2 = B_HEADS * 2 * B_QK_DIM
B_V = B_HEADS * B_V_DIM
GATE_EVEN = A_Q + B_V
IN_EVEN = A_Q + 2 * A_KV + 2 * B_QK2 + B_V + GATE_EVEN
C_HEADS = N_HEADS
C_WIDTH = C_HEADS * HEAD_DIM
C_PATTERNS = ((128, 1), (512, 4), (2048, 16))
IN_ODD = 4 * C_WIDTH
GRID_W = 64
ROPE_THETA = 10000.0
ROPE_PAIRS = HEAD_DIM // 4
Q_BLOCK = 128
NORM_EPS = 1e-6
SUBLN_EPS = 1e-5
NEG_INF = -1e30

kernel_name = 'hybrid_gqa_diff_dilated_encoder'


def rms_norm(x, g, eps=NORM_EPS):
    xf = x.astype(jnp.float32)
    y = xf * lax.rsqrt(jnp.mean(xf * xf, axis=-1, keepdims=True) + eps)
    return (y * g.astype(jnp.float32)).astype(x.dtype)


def alibi_slopes(n):
    return jnp.exp2(-8.0 * jnp.arange(1, n + 1, dtype=jnp.float32) / n)


def axial_rope_tables(s):
    rows = s // GRID_W
    row_ids = jnp.broadcast_to(jnp.arange(rows)[:, None], (rows, GRID_W)).reshape(s).astype(jnp.float32)
    col_ids = jnp.broadcast_to(jnp.arange(GRID_W)[None, :], (rows, GRID_W)).reshape(s).astype(jnp.float32)
    inv_freq = ROPE_THETA ** (-jnp.arange(ROPE_PAIRS, dtype=jnp.float32) / ROPE_PAIRS)
    ang_r = row_ids[:, None] * inv_freq[None, :]
    ang_c = col_ids[:, None] * inv_freq[None, :]
    return jnp.cos(ang_r), jnp.sin(ang_r), jnp.cos(ang_c), jnp.sin(ang_c)


def _rope_section(xs, cos, sin):
    x1, x2 = xs[..., :ROPE_PAIRS], xs[..., ROPE_PAIRS:]
    c = cos[None, :, None, :]
    sn = sin[None, :, None, :]
    return jnp.concatenate([x1 * c - x2 * sn, x2 * c + x1 * sn], axis=-1)


def apply_axial_rope(x, tables):
    cr, sr, cc, sc = tables
    xf = x.astype(jnp.float32)
    half = HEAD_DIM // 2
    out = jnp.concatenate([_rope_section(xf[..., :half], cr, sr),
                           _rope_section(xf[..., half:], cc, sc)], axis=-1)
    return out.astype(x.dtype)


def gqa_attention(q, k, v):
    b, s, _, d = q.shape
    nb = s // Q_BLOCK
    scale = 1.0 / math.sqrt(d)
    qb = q.reshape(b, nb, Q_BLOCK, A_KV_HEADS, A_GROUP, d).transpose(1, 0, 2, 3, 4, 5)

    def block(qi):
        sc = jnp.einsum('bqkgd,bskd->bkgqs', qi, k).astype(jnp.float32) * scale
        p = jax.nn.softmax(sc, axis=-1)
        return jnp.einsum('bkgqs,bskd->bqkgd', p.astype(v.dtype), v)

    o = lax.map(block, qb)
    return o.transpose(1, 0, 2, 3, 4, 5).reshape(b, s, A_HEADS * d)


def diff_attention(q1, q2, k1, k2, v, lam, slopes):
    b, s, h, dq = q1.shape
    nb = s // Q_BLOCK
    scale = 1.0 / math.sqrt(dq)
    pos = jnp.arange(s)
    q1b = q1.reshape(b, nb, Q_BLOCK, h, dq).transpose(1, 0, 2, 3, 4)
    q2b = q2.reshape(b, nb, Q_BLOCK, h, dq).transpose(1, 0, 2, 3, 4)
    starts = jnp.arange(nb) * Q_BLOCK

    def block(args):
        q1i, q2i, t0 = args
        tq = t0 + jnp.arange(Q_BLOCK)
        dist = jnp.abs(tq[:, None] - pos[None, :]).astype(jnp.float32)
        bias = -slopes[:, None, None] * dist[None]
        s1 = jnp.einsum('bqhd,bshd->bhqs', q1i, k1).astype(jnp.float32) * scale + bias
        s2 = jnp.einsum('bqhd,bshd->bhqs', q2i, k2).astype(jnp.float32) * scale + bias
        p = jax.nn.softmax(s1, axis=-1) - lam * jax.nn.softmax(s2, axis=-1)
        return jnp.einsum('bhqs,bshd->bqhd', p.astype(v.dtype), v)

    o = lax.map(block, (q1b, q2b, starts))
    return o.transpose(1, 0, 2, 3, 4).reshape(b, s, h, v.shape[-1])


def dilated_window_attention(q, k, v, r, half, slopes):
    b, s, h, d = q.shape
    L = s // r
    nb = -(-L // half)
    lp = nb * half
    scale = 1.0 / math.sqrt(d)

    def sub(t):
        return t.reshape(b, L, r, h, d)

    qs = jnp.pad(sub(q), ((0, 0), (0, lp - L), (0, 0), (0, 0), (0, 0))).reshape(b, nb, half, r, h, d)
    pad_k = ((0, 0), (half, lp - L + half), (0, 0), (0, 0), (0, 0))
    kp = jnp.pad(sub(k), pad_k)
    vp = jnp.pad(sub(v), pad_k)
    win = jnp.arange(nb)[:, None] * half + jnp.arange(3 * half)[None, :]
    kb = jnp.take(kp, win, axis=1)
    vb = jnp.take(vp, win, axis=1)
    mq = jnp.arange(nb)[:, None] * half + jnp.arange(half)[None, :]
    mk = win - half
    rel = mk[:, None, :] - mq[:, :, None]
    valid = (jnp.abs(rel) <= half) & (mk[:, None, :] >= 0) & (mk[:, None, :] < L)
    dist = (jnp.abs(rel) * r).astype(jnp.float32)
    bias = -slopes[None, :, None, None] * dist[:, None]
    sc = jnp.einsum('bnqchd,bnkchd->bnchqk', qs, kb).astype(jnp.float32) * scale + bias[None, :, None]
    sc = jnp.where(valid[None, :, None, None], sc, NEG_INF)
    m = jnp.max(sc, axis=-1, keepdims=True)
    e = jnp.exp(sc - m)
    den = jnp.sum(e, axis=-1, keepdims=True)
    o = jnp.einsum('bnchqk,bnkchd->bnqchd', (e / den).astype(v.dtype), vb)
    lse = (m + jnp.log(den))[..., 0]
    o = o.reshape(b, lp, r, h, d)[:, :L].reshape(b, s, h, d)
    lse = lse.transpose(0, 1, 4, 2, 3).reshape(b, lp, r, h)[:, :L].reshape(b, s, h)
    return o, lse


def setup_inputs(seed: int = 0) -> dict:
    key = jax.random.key(seed)
    ks = jax.random.split(key, 16)
    n_even = (DEPTH + 1) // 2
    n_odd = DEPTH // 2
    f32 = jnp.float32

    def gain(k, shape):
        return 1.0 + 0.02 * jax.random.normal(k, shape, f32)

    return {
        'x': jax.random.normal(ks[0], (BATCH, SEQ, D_MODEL), f32),
        'ln_even_g': gain(ks[1], (n_even, D_MODEL)),
        'w_in_even': jax.random.normal(ks[2], (n_even, D_MODEL, IN_EVEN), f32) * D_MODEL ** -0.5,
        'a_q_norm_g': gain(ks[3], (n_even, HEAD_DIM)),
        'a_k_norm_g': gain(ks[4], (n_even, HEAD_DIM)),
        'b_lambda_q1': 0.1 * jax.random.normal(ks[5], (n_even, B_QK_DIM), f32),
        'b_lambda_k1': 0.1 * jax.random.normal(ks[6], (n_even, B_QK_DIM), f32),
        'b_lambda_q2': 0.1 * jax.random.normal(ks[7], (n_even, B_QK_DIM), f32),
        'b_lambda_k2': 0.1 * jax.random.normal(ks[8], (n_even, B_QK_DIM), f32),
        'b_subln_g': gain(ks[9], (n_even, B_V_DIM)),
        'w_out_even': jax.random.normal(ks[10], (n_even, MIX_WIDTH, D_MODEL), f32) * MIX_WIDTH ** -0.5,
        'ln_odd_g': gain(ks[11], (n_odd, D_MODEL)),
        'w_in_odd': jax.random.normal(ks[12], (n_odd, D_MODEL, IN_ODD), f32) * D_MODEL ** -0.5,
        'w_out_odd': jax.random.normal(ks[13], (n_odd, C_WIDTH, D_MODEL), f32) * C_WIDTH ** -0.5,
        'final_norm_g': gain(ks[14], (D_MODEL,)),
    }


def reference(x, ln_even_g, w_in_even, a_q_norm_g, a_k_norm_g, b_lambda_q1, b_lambda_k1,
              b_lambda_q2, b_lambda_k2, b_subln_g, w_out_even, ln_odd_g, w_in_odd, w_out_odd,
              final_norm_g):
    b, s, _ = x.shape
    rope_tables = axial_rope_tables(s)
    slopes_b = alibi_slopes(B_HEADS)
    slopes_c = alibi_slopes(C_HEADS)
    even_splits = np.cumsum([A_Q, A_KV, A_KV, B_QK2, B_QK2, B_V]).tolist()
    odd_splits = [C_WIDTH, 2 * C_WIDTH, 3 * C_WIDTH]
    h = x
    for layer in range(DEPTH):
        i = layer // 2
        if layer % 2 == 0:
            u = rms_norm(h, ln_even_g[i])
            proj = jnp.einsum('bsd,de->bse', u, w_in_even[i])
            qa, ka, va, qb, kb, vb, gate = jnp.split(proj, even_splits, axis=-1)
            qa = apply_axial_rope(rms_norm(qa.reshape(b, s, A_HEADS, HEAD_DIM), a_q_norm_g[i]), rope_tables)
            ka = apply_axial_rope(rms_norm(ka.reshape(b, s, A_KV_HEADS, HEAD_DIM), a_k_norm_g[i]), rope_tables)
            va = va.reshape(b, s, A_KV_HEADS, HEAD_DIM)
            ya = gqa_attention(qa, ka, va)
            qb = qb.reshape(b, s, B_HEADS, 2, B_QK_DIM)
            kb = kb.reshape(b, s, B_HEADS, 2, B_QK_DIM)
            vb = vb.reshape(b, s, B_HEADS, B_V_DIM)
            lambda_init = 0.8 - 0.6 * math.exp(-0.3 * layer)
            lam = (jnp.exp(jnp.sum(b_lambda_q1[i].astype(jnp.float32) * b_lambda_k1[i].astype(jnp.float32)))
                   - jnp.exp(jnp.sum(b_lambda_q2[i].astype(jnp.float32) * b_lambda_k2[i].astype(jnp.float32)))
                   + lambda_init)
            yb = diff_attention(qb[:, :, :, 0], qb[:, :, :, 1], kb[:, :, :, 0], kb[:, :, :, 1], vb, lam, slopes_b)
            yb = (rms_norm(yb, b_subln_g[i], SUBLN_EPS) * (1.0 - lambda_init)).reshape(b, s, B_V)
            y = jnp.concatenate([ya, yb], axis=-1) * jax.nn.silu(gate)
            h = h + jnp.einsum('bse,ed->bsd', y, w_out_even[i])
        else:
            u = rms_norm(h, ln_odd_g[i])
            proj = jnp.einsum('bsd,de->bse', u, w_in_odd[i])
            qc, kc, vc, gate = jnp.split(proj, odd_splits, axis=-1)
            qc = qc.reshape(b, s, C_HEADS, HEAD_DIM)
            kc = kc.reshape(b, s, C_HEADS, HEAD_DIM)
            vc = vc.reshape(b, s, C_HEADS, HEAD_DIM)
            outs, lses = [], []
            for window, dil in C_PATTERNS:
                o, l = dilated_window_attention(qc, kc, vc, dil, window // (2 * dil), slopes_c)
                outs.append(o)
                lses.append(l)
            wts = jax.nn.softmax(jnp.stack(lses, axis=0), axis=0)
            yc = jnp.sum(wts[..., None].astype(vc.dtype) * jnp.stack(outs, axis=0), axis=0)
            y = yc.reshape(b, s, C_WIDTH) * jax.nn.silu(gate)
            h = h + jnp.einsum('bse,ed->bsd', y, w_out_odd[i])
    return rms_norm(h, final_norm_g)
```

```cpp
#include <hip/hip_runtime.h>
#include <hip/hip_cooperative_groups.h>
#include <cstdio>
#include <cstdint>
namespace cg = cooperative_groups;
namespace pg8 {
#define PG8_LAS __attribute__((address_space(3)))
typedef unsigned short bf16_t;
typedef short bf16x8 __attribute__((ext_vector_type(8)));
typedef float f32x4 __attribute__((ext_vector_type(4)));
typedef unsigned u32x4 __attribute__((ext_vector_type(4)));
constexpr int BM = 256, BK = 64, HALF = 128, HTB = HALF * BK * 2  , STAGE_BYTES = 8 * HTB, NXCD = 8, WGM = 8;

__host__ __device__ __forceinline__ int lds_byte(int r, int c) { const int st = (r >> 4) * 2 + (c >> 5), rr = r & 15, cc = c & 31, ob = rr * 64 + cc * 2; return st * 1024 + (ob ^ (((ob >> 9) & 1) << 5)); }
__host__ __device__ __forceinline__ void stage_rc(int b, int& R, int& C) { const int st = b / 1024, sb = b % 1024, swz = sb ^ (((sb >> 9) & 1) << 5); R = (st >> 1) * 16 + swz / 64; C = (st & 1) * 32 + (swz % 64) / 2; }
__host__ __device__ __forceinline__ int perm32(int rho) { const int n = rho >> 4, i = rho & 15; return 8 * (i >> 2) + 4 * n + (i & 3); }

struct Unit { int pm, pn; };
struct Gemm { const bf16_t* A; const bf16_t* Bt; int M, N, K; };

struct StaticOrder {
    int nM, nN, nwg, G, c;
    __host__ __device__ void init(int M, int N, int G_, int c_) { nM = M / BM; nN = N / BM; nwg = nM * nN; G = G_; c = c_; }
    __host__ __device__ bool next(int i, Unit& u) const {
        const long L = (long)i * G + c; if (L >= nwg) return false;
        int wgid = (int)L; { const int q = nwg / NXCD, r = nwg % NXCD, xcd = wgid % NXCD, off = wgid / NXCD; wgid = (xcd < r ? xcd * (q + 1) : r * (q + 1) + (xcd - r) * q) + off; }
        const int nig = WGM * nN, gid = wgid / nig, fm = gid * WGM, gsz = (nM - fm) < WGM ? (nM - fm) : WGM;
        u.pm = fm + ((wgid % nig) % gsz); u.pn = (wgid % nig) / gsz; return true;
    }
    __device__ __forceinline__ void a_ready(const Unit&) const {}
    __device__ __forceinline__ void done(const Unit&) const {}
};

__device__ __forceinline__ unsigned cvt_pk_bf16(float lo, float hi) { unsigned r; asm volatile("v_cvt_pk_bf16_f32 %0, %1, %2" : "=v"(r) : "v"(lo), "v"(hi)); return r; }
typedef float f32x2 __attribute__((ext_vector_type(2)));
__device__ __forceinline__ f32x2 gelu_pk(f32x2 v) {
    const f32x2 av = __builtin_elementwise_abs(v), d = av * 0.2316418882f + 1.0f;
    f32x2 t; t.x = __builtin_amdgcn_rcpf(d.x); t.y = __builtin_amdgcn_rcpf(d.y);
    f32x2 q = t * 0.5307027145f + (-0.7265760135f); q = q * t + 0.7107068705f; q = q * t + (-0.142248368f); q = q * t + 0.127414796f; q = q * t;
    const f32x2 s = (v * v) * (-0.72134752044f);
    f32x2 e; e.x = __builtin_amdgcn_exp2f(s.x); e.y = __builtin_amdgcn_exp2f(s.y);
    const f32x2 m = v * (q * e), r = v - m;
    f32x2 o; o.x = v.x < 0.f ? m.x : r.x; o.y = v.y < 0.f ? m.y : r.y; return o;
}

template <int ACT  > struct EpiBf16 {
    static constexpr bool PERM = true, AFTER_DRAIN = false; static_assert(ACT == 0 || ACT == 1, "EpiBf16: ACT is 0 (none) or 1 (gelu_pk)");
    bf16_t* O; int ldc; const float* bias; int split_cols; size_t split_stride; float scale0;
    __device__ __forceinline__ void operator()(const f32x4 (&acc)[2][2][4][2], const Unit& u, int wr, int wc, int fr, int fq) const {
        const int row0 = u.pm * BM + wr * 64 + fr; int colt = u.pn * BM; bf16_t* base = O;
        float sc = 1.f; if (split_cols) { const int t = colt / split_cols; base += (size_t)t * split_stride; colt -= t * split_cols; if (t == 0) sc = scale0; }
        const int col0 = colt + wc * 32 + 8 * fq, bcol0 = u.pn * BM + wc * 32 + 8 * fq;
        f32x4 bv[2][2];
#pragma unroll
        for (int bj = 0; bj < 2; ++bj)
#pragma unroll
            for (int n = 0; n < 2; ++n) bv[bj][n] = bias ? *(const f32x4*)(bias + bcol0 + bj * HALF + 4 * n) : (f32x4){0.f, 0.f, 0.f, 0.f};
#pragma unroll
        for (int ai = 0; ai < 2; ++ai)
#pragma unroll
            for (int m = 0; m < 4; ++m) { bf16_t* rowp = base + (size_t)(row0 + ai * HALF + m * 16) * ldc + col0;
#pragma unroll
                for (int bj = 0; bj < 2; ++bj) { f32x4 v0 = acc[ai][bj][m][0] + bv[bj][0], v1 = acc[ai][bj][m][1] + bv[bj][1];
                    if (ACT == 1) { f32x2 a = gelu_pk((f32x2){v0[0], v0[1]}), b = gelu_pk((f32x2){v0[2], v0[3]}), c = gelu_pk((f32x2){v1[0], v1[1]}), d = gelu_pk((f32x2){v1[2], v1[3]});
                        v0 = (f32x4){a.x, a.y, b.x, b.y}; v1 = (f32x4){c.x, c.y, d.x, d.y}; }
                    v0 = v0 * sc; v1 = v1 * sc; u32x4 w; w.x = cvt_pk_bf16(v0[0], v0[1]); w.y = cvt_pk_bf16(v0[2], v0[3]); w.z = cvt_pk_bf16(v1[0], v1[1]); w.w = cvt_pk_bf16(v1[2], v1[3]);
                    *(u32x4*)(rowp + bj * HALF) = w; } }
    }
};typedef unsigned u32x2 __attribute__((ext_vector_type(2)));
struct EpiResidA {
    static constexpr bool PERM = false, AFTER_DRAIN = false;
    bf16_t* hg; const float* g_old; const float* rms_old; const float* g; float* rowss; int ldc;
    __device__ __forceinline__ void operator()(const f32x4 (&acc)[2][2][4][2], const Unit& u, int wr, int wc, int fr, int fq) const {
        const int col0 = u.pn * BM + wc * 32 + 4 * fq;
        f32x4 gi[2][2], gg[2][2];
#pragma unroll
        for (int bj = 0; bj < 2; ++bj)
#pragma unroll
            for (int n = 0; n < 2; ++n) { const f32x4 go = *(const f32x4*)(g_old + col0 + bj * HALF + n * 16); gg[bj][n] = *(const f32x4*)(g + col0 + bj * HALF + n * 16);
                gi[bj][n] = (f32x4){__builtin_amdgcn_rcpf(go[0]), __builtin_amdgcn_rcpf(go[1]), __builtin_amdgcn_rcpf(go[2]), __builtin_amdgcn_rcpf(go[3])}; }
#pragma unroll
        for (int ai = 0; ai < 2; ++ai) {
            u32x2 hw[4][2][2]; float rm[4];
#pragma unroll
            for (int m = 0; m < 4; ++m) { const int row = u.pm * BM + ai * HALF + wr * 64 + m * 16 + fr; const size_t off = (size_t)row * ldc + col0;
                rm[m] = rms_old[row];
#pragma unroll
                for (int bj = 0; bj < 2; ++bj)
#pragma unroll
                    for (int n = 0; n < 2; ++n) hw[m][bj][n] = *(const u32x2*)(hg + off + bj * HALF + n * 16); }
            asm volatile("" ::: "memory");
#pragma unroll
            for (int m = 0; m < 4; ++m) {
                const int row = u.pm * BM + ai * HALF + wr * 64 + m * 16 + fr;
                const size_t off = (size_t)row * ldc + col0;
                float ss = 0.f;
#pragma unroll
                for (int bj = 0; bj < 2; ++bj)
#pragma unroll
                    for (int n = 0; n < 2; ++n) {
                        const int co = bj * HALF + n * 16;
                        const u32x2 h = hw[m][bj][n];
                        const f32x4 xr = (f32x4){__uint_as_float(h.x << 16), __uint_as_float(h.x & 0xffff0000u), __uint_as_float(h.y << 16), __uint_as_float(h.y & 0xffff0000u)};
                        const f32x4 v = xr * gi[bj][n] * rm[m] + acc[ai][bj][m][n];
                        ss += (v[0] * v[0] + v[1] * v[1]) + (v[2] * v[2] + v[3] * v[3]);
                        u32x2 w; w.x = cvt_pk_bf16(v[0] * gg[bj][n][0], v[1] * gg[bj][n][1]); w.y = cvt_pk_bf16(v[2] * gg[bj][n][2], v[3] * gg[bj][n][3]);
                        *(u32x2*)(hg + off + co) = w;
                    }
                ss += __shfl_xor(ss, 16); ss += __shfl_xor(ss, 32);
                if (fq == 0) atomicAdd(rowss + row, ss);
            }
            asm volatile("" ::: "memory");
        }
    }
};
struct EpiResidB {
    static constexpr bool PERM = false, AFTER_DRAIN = false;
    bf16_t* hg; const float* g; float* rowss; int ldc;
    __device__ __forceinline__ void operator()(const f32x4 (&acc)[2][2][4][2], const Unit& u, int wr, int wc, int fr, int fq) const {
        const int col0 = u.pn * BM + wc * 32 + 4 * fq;
        u32x2 hw[2][4][2][2];
#pragma unroll
        for (int ai = 0; ai < 2; ++ai)
#pragma unroll
            for (int m = 0; m < 4; ++m) { const size_t off = (size_t)(u.pm * BM + ai * HALF + wr * 64 + m * 16 + fr) * ldc + col0;
#pragma unroll
                for (int bj = 0; bj < 2; ++bj)
#pragma unroll
                    for (int n = 0; n < 2; ++n) hw[ai][m][bj][n] = *(const u32x2*)(hg + off + bj * HALF + n * 16); }
        f32x4 gi[2][2];
#pragma unroll
        for (int bj = 0; bj < 2; ++bj)
#pragma unroll
            for (int n = 0; n < 2; ++n) { const f32x4 gg = *(const f32x4*)(g + col0 + bj * HALF + n * 16);
                gi[bj][n] = (f32x4){__builtin_amdgcn_rcpf(gg[0]), __builtin_amdgcn_rcpf(gg[1]), __builtin_amdgcn_rcpf(gg[2]), __builtin_amdgcn_rcpf(gg[3])}; }
        asm volatile("" ::: "memory");
#pragma unroll
        for (int ai = 0; ai < 2; ++ai)
#pragma unroll
            for (int m = 0; m < 4; ++m) {
                const int row = u.pm * BM + ai * HALF + wr * 64 + m * 16 + fr;
                const size_t off = (size_t)row * ldc + col0;
                float ss = 0.f;
#pragma unroll
                for (int bj = 0; bj < 2; ++bj)
#pragma unroll
                    for (int n = 0; n < 2; ++n) {
                        const int co = bj * HALF + n * 16;
                        const u32x2 h = hw[ai][m][bj][n];
                        const f32x4 h1 = (f32x4){__uint_as_float(h.x << 16), __uint_as_float(h.x & 0xffff0000u), __uint_as_float(h.y << 16), __uint_as_float(h.y & 0xffff0000u)};
                        const f32x4 v = h1 * gi[bj][n] + acc[ai][bj][m][n];
                        ss += (v[0] * v[0] + v[1] * v[1]) + (v[2] * v[2] + v[3] * v[3]);
                        u32x2 w; w.x = cvt_pk_bf16(v[0], v[1]); w.y = cvt_pk_bf16(v[2], v[3]);
                        *(u32x2*)(hg + off + co) = w;
                    }
                ss += __shfl_xor(ss, 16); ss += __shfl_xor(ss, 32);
                if (fq == 0) atomicAdd(rowss + row, ss);
            }
    }
};
struct EpiBf16RS {
    static constexpr bool PERM = true, AFTER_DRAIN = false;
    bf16_t* O; int ldc; const float* rowss; float inv_n, eps;
    __device__ __forceinline__ void operator()(const f32x4 (&acc)[2][2][4][2], const Unit& u, int wr, int wc, int fr, int fq) const {
        const int row0 = u.pm * BM + wr * 64 + fr;
        float scv[2][4];
#pragma unroll
        for (int ai = 0; ai < 2; ++ai)
#pragma unroll
            for (int m = 0; m < 4; ++m) scv[ai][m] = rowss ? rowss[row0 + ai * HALF + m * 16] : 0.f;
        asm volatile("" ::: "memory");
#pragma unroll
        for (int ai = 0; ai < 2; ++ai)
#pragma unroll
            for (int m = 0; m < 4; ++m) { const int row = row0 + ai * HALF + m * 16;
                bf16_t* rowp = O + ((size_t)((u.pn * 2) * 16 + (row >> 11)) * 2048 + (row & 2047)) * 128 + wc * 32 + 8 * fq;
                const float sc = rowss ? __builtin_amdgcn_rsqf(scv[ai][m] * inv_n + eps) : 1.f;
#pragma unroll
                for (int bj = 0; bj < 2; ++bj) { const f32x4 v0 = acc[ai][bj][m][0] * sc, v1 = acc[ai][bj][m][1] * sc;
                    u32x4 w; w.x = cvt_pk_bf16(v0[0], v0[1]); w.y = cvt_pk_bf16(v0[2], v0[3]); w.z = cvt_pk_bf16(v1[0], v1[1]); w.w = cvt_pk_bf16(v1[2], v1[3]);
                    *(u32x4*)(rowp + (size_t)bj * (16 * 2048 * 128)) = w; } }
    }
};
template <class Epi, class Sched, bool ALIGN_EPI = false, bool SP2 = false>
__device__ __forceinline__ void gemm_phase(PG8_LAS unsigned char* lds, const Gemm g, const Sched& S, const Epi& E) {
    const int tid = threadIdx.x, wid = __builtin_amdgcn_readfirstlane(tid >> 6), lane = tid & 63, wr = wid >> 2, wc = wid & 3, fr = lane & 15, fq = lane >> 4;
    const int K = g.K, nt = K / BK;
    unsigned voffA[2], voffB[2];
#pragma unroll
    for (int i = 0; i < 2; ++i) { int R, C; stage_rc(tid * 16 + i * 8192, R, C); const int Rb = Epi::PERM ? ((R & ~31) + perm32(R & 31)) : R;
        voffA[i] = (unsigned)(R * K + C) * 2u; voffB[i] = (unsigned)(Rb * K + C) * 2u; }
    const size_t kstep = (size_t)(BK * 2);
    const size_t hstep = (size_t)HALF * K * 2;
    const size_t tstep = 2 * hstep;
    const unsigned ldsw = (unsigned)wid * 1024u;
    const int aoff = lds_byte(wr * 64 + fr, fq * 8), boff = lds_byte(wc * 32 + fr, fq * 8);
#define PG8_SA(b, h) (((b) * 2 + (h)) * HTB)
#define PG8_SB(b, h) ((4 + (b) * 2 + (h)) * HTB)
#define PG8_STAGE(bufoff, gbase, voff) do { _Pragma("unroll") for (int _i = 0; _i < 2; ++_i) \
        __builtin_amdgcn_global_load_lds((const unsigned*)((const char*)(gbase) + (voff)[_i]), (PG8_LAS unsigned*)(lds + (bufoff) + ldsw + _i * 8192), 16, 0, 0); } while (0)
#define PG8_LDA(dst, b, h) do { _Pragma("unroll") for (int m = 0; m < 4; ++m) _Pragma("unroll") for (int k = 0; k < 2; ++k) dst[m][k] = *(const PG8_LAS bf16x8*)(lds + PG8_SA(b, h) + aoff + m * 2048 + k * 1024); } while (0)
#define PG8_LDB(dst, b, h) do { _Pragma("unroll") for (int n = 0; n < 2; ++n) _Pragma("unroll") for (int k = 0; k < 2; ++k) dst[n][k] = *(const PG8_LAS bf16x8*)(lds + PG8_SB(b, h) + boff + n * 2048 + k * 1024); } while (0)
#define PG8_MMA(ai, bj, At, Bt) do { __builtin_amdgcn_s_setprio(1); _Pragma("unroll") for (int m = 0; m < 4; ++m) _Pragma("unroll") for (int n = 0; n < 2; ++n) _Pragma("unroll") for (int k = 0; k < 2; ++k) \
        acc[ai][bj][m][n] = __builtin_amdgcn_mfma_f32_16x16x32_bf16(Bt[n][k], At[m][k], acc[ai][bj][m][n], 0, 0, 0); __builtin_amdgcn_s_setprio(0); } while (0)
#define PG8_WAIT_V(n) asm volatile("s_waitcnt vmcnt(" #n ")" ::: "memory")
#define PG8_WAIT_L(n) asm volatile("s_waitcnt lgkmcnt(" #n ")" ::: "memory")
#define PG8_BAR __builtin_amdgcn_s_barrier()
#define PG8_SCHED __builtin_amdgcn_sched_barrier(0)
    Unit cur, nxt; int ui = 0;
    if (!S.next(0, cur)) return;
    f32x4 acc[2][2][4][2];
#pragma unroll
    for (int a = 0; a < 2; ++a)
#pragma unroll
        for (int b = 0; b < 2; ++b)
#pragma unroll
            for (int m = 0; m < 4; ++m)
#pragma unroll
                for (int n = 0; n < 2; ++n) acc[a][b][m][n] = (f32x4){0.f, 0.f, 0.f, 0.f};
    bf16x8 At[4][2], B0[2][2], B1[2][2];
    const char* cA = (const char*)g.A + (size_t)cur.pm * tstep; const char* cB = (const char*)g.Bt + (size_t)cur.pn * tstep;
    S.a_ready(cur);
    if constexpr (SP2) {
        PG8_STAGE(PG8_SB(0, 0), cB, voffB); PG8_STAGE(PG8_SB(0, 1), cB + hstep, voffB); PG8_STAGE(PG8_SA(0, 0), cA, voffA); PG8_STAGE(PG8_SA(0, 1), cA + hstep, voffA);
        if (wr == 1) PG8_BAR;
        PG8_WAIT_V(2); PG8_BAR;
        PG8_STAGE(PG8_SB(1, 0), cB + kstep, voffB); PG8_STAGE(PG8_SA(1, 0), cA + kstep, voffA); PG8_STAGE(PG8_SB(1, 1), cB + hstep + kstep, voffB);
        PG8_WAIT_V(6); PG8_BAR;
    } else {
        PG8_STAGE(PG8_SB(0, 0), cB, voffB); PG8_STAGE(PG8_SA(0, 0), cA, voffA); PG8_STAGE(PG8_SB(0, 1), cB + hstep, voffB); PG8_STAGE(PG8_SA(0, 1), cA + hstep, voffA);
        if (wr == 1) PG8_BAR;
        PG8_WAIT_V(4); PG8_BAR;
        PG8_STAGE(PG8_SB(1, 0), cB + kstep, voffB); PG8_STAGE(PG8_SA(1, 0), cA + kstep, voffA); PG8_STAGE(PG8_SB(1, 1), cB + hstep + kstep, voffB);
        PG8_WAIT_V(6); PG8_BAR;
    }
    for (;;) {
        const bool has_next = S.next(ui + 1, nxt);
        const char* nA = has_next ? (const char*)g.A + (size_t)nxt.pm * tstep : cA; const char* nB = has_next ? (const char*)g.Bt + (size_t)nxt.pn * tstep : cB;
        for (int t = 0; t < nt; t += 2) {
            const bool last = (t == nt - 2);
            const char* a1 = cA + (size_t)(t + 1) * kstep;
            const char* a2 = last ? nA : cA + (size_t)(t + 2) * kstep; const char* b2 = last ? nB : cB + (size_t)(t + 2) * kstep;
            const char* a3 = a2 + kstep; const char* b3 = b2 + kstep;
            if (last && has_next) S.a_ready(nxt);
            if constexpr (SP2) {
            PG8_LDB(B0, 0, 0); PG8_LDB(B1, 0, 1); PG8_SCHED; PG8_LDA(At, 0, 0); PG8_STAGE(PG8_SA(1, 1), a1 + hstep, voffA);
            PG8_WAIT_V(8); PG8_WAIT_L(0); PG8_BAR; PG8_MMA(0, 0, At, B0); PG8_MMA(0, 1, At, B1); PG8_BAR; PG8_SCHED;
            PG8_LDA(At, 0, 1); PG8_STAGE(PG8_SB(0, 0), b2, voffB); PG8_STAGE(PG8_SB(0, 1), b2 + hstep, voffB); PG8_STAGE(PG8_SA(0, 0), a2, voffA);
            PG8_WAIT_V(8); PG8_WAIT_L(0); PG8_BAR; PG8_MMA(1, 0, At, B0); PG8_MMA(1, 1, At, B1); PG8_BAR; PG8_SCHED;
            PG8_LDB(B0, 1, 0); PG8_LDB(B1, 1, 1); PG8_SCHED; PG8_LDA(At, 1, 0); PG8_STAGE(PG8_SA(0, 1), a2 + hstep, voffA);
            PG8_WAIT_V(8); PG8_WAIT_L(0); PG8_BAR; PG8_MMA(0, 0, At, B0); PG8_MMA(0, 1, At, B1); PG8_BAR; PG8_SCHED;
            PG8_LDA(At, 1, 1); PG8_STAGE(PG8_SB(1, 0), b3, voffB); PG8_STAGE(PG8_SB(1, 1), b3 + hstep, voffB); PG8_STAGE(PG8_SA(1, 0), a3, voffA);
            PG8_WAIT_V(8); PG8_WAIT_L(0); PG8_BAR; PG8_MMA(1, 0, At, B0); PG8_MMA(1, 1, At, B1); PG8_BAR; PG8_SCHED;
            } else {
            PG8_LDB(B0, 0, 0); PG8_SCHED; PG8_LDA(At, 0, 0); PG8_STAGE(PG8_SA(1, 1), a1 + hstep, voffA);
            PG8_WAIT_L(8); PG8_BAR; PG8_WAIT_L(0); PG8_MMA(0, 0, At, B0); PG8_BAR; PG8_SCHED;
            PG8_LDB(B1, 0, 1); PG8_STAGE(PG8_SB(0, 0), b2, voffB);
            PG8_BAR; PG8_WAIT_L(0); PG8_MMA(0, 1, At, B1); PG8_BAR;
            PG8_LDA(At, 0, 1); PG8_STAGE(PG8_SA(0, 0), a2, voffA);
            PG8_BAR; PG8_WAIT_L(0); PG8_MMA(1, 0, At, B0); PG8_BAR; PG8_SCHED;
            PG8_STAGE(PG8_SB(0, 1), b2 + hstep, voffB);
            PG8_WAIT_V(6); PG8_BAR; PG8_MMA(1, 1, At, B1); PG8_BAR;
            PG8_LDB(B0, 1, 0); PG8_SCHED; PG8_LDA(At, 1, 0); PG8_STAGE(PG8_SA(0, 1), a2 + hstep, voffA);
            PG8_WAIT_L(8); PG8_BAR; PG8_WAIT_L(0); PG8_MMA(0, 0, At, B0); PG8_BAR; PG8_SCHED;
            PG8_LDB(B1, 1, 1); PG8_STAGE(PG8_SB(1, 0), b3, voffB);
            PG8_BAR; PG8_WAIT_L(0); PG8_MMA(0, 1, At, B1); PG8_BAR;
            PG8_LDA(At, 1, 1); PG8_STAGE(PG8_SA(1, 0), a3, voffA);
            PG8_BAR; PG8_WAIT_L(0); PG8_MMA(1, 0, At, B0); PG8_BAR; PG8_SCHED;
            PG8_STAGE(PG8_SB(1, 1), b3 + hstep, voffB);
            PG8_WAIT_V(6); PG8_BAR; PG8_MMA(1, 1, At, B1); PG8_BAR;
            }
        }
        if constexpr (ALIGN_EPI) { if (wr == 0) PG8_BAR; }
        if constexpr (!Epi::AFTER_DRAIN) { E(acc, cur, wr, wc, fr, fq); S.done(cur); }
        if (!has_next) break;
#pragma unroll
        for (int a = 0; a < 2; ++a)
#pragma unroll
            for (int b = 0; b < 2; ++b)
#pragma unroll
                for (int m = 0; m < 4; ++m)
#pragma unroll
                    for (int n = 0; n < 2; ++n) acc[a][b][m][n] = (f32x4){0.f, 0.f, 0.f, 0.f};
        cur = nxt; cA = nA; cB = nB; ++ui;
        if constexpr (ALIGN_EPI) { if (wr == 1) PG8_BAR; }
    }
    PG8_WAIT_V(0);
    if constexpr (!ALIGN_EPI) { if (wr == 0) PG8_BAR; }
    PG8_BAR;
    if constexpr (Epi::AFTER_DRAIN) { E.fused(acc, cur, wr, wc, fr, fq, lds, wid, lane); S.done(cur); }
#undef PG8_SA
#undef PG8_SB
#undef PG8_STAGE
#undef PG8_LDA
#undef PG8_LDB
#undef PG8_MMA
#undef PG8_WAIT_V
#undef PG8_WAIT_L
#undef PG8_BAR
#undef PG8_SCHED
}
}
namespace att {
typedef unsigned short bf16_t;
using bf16x8 = __attribute__((ext_vector_type(8))) short;
using s16x4  = __attribute__((ext_vector_type(4))) short;
using f32x16 = __attribute__((ext_vector_type(16))) float;
using u32x4  = __attribute__((ext_vector_type(4))) unsigned;
using f32x4v = __attribute__((ext_vector_type(4))) float;
constexpr int NW = 8, QBLK = 32, KVBLK = 64;
constexpr int SHM_V = KVBLK * 128 * 2, SHM_K = KVBLK * 128 * 2;
constexpr int ATT_WS_OFF = 2 * SHM_V + 2 * SHM_K;
constexpr int ATT_STG_OFF = ATT_WS_OFF + NW * 64 * 4;
constexpr int STG_PITCH = 136, STG_BYTES = 32 * STG_PITCH * 2;
constexpr int ATT_LDS_BYTES = ATT_STG_OFF + NW * STG_BYTES;
constexpr float LOG2E = 1.4426950408889634f;
constexpr float THR = 8.f;
#define KSWZ(row, colB) ((row) * 256 + ((colB) ^ (((row) & 7) << 4)))
#define SBAR() __builtin_amdgcn_sched_barrier(0)
__device__ __forceinline__ int crow(int r, int hi) { return (r & 3) + 8 * (r >> 2) + 4 * hi; }
__device__ __forceinline__ unsigned cvtpk(float lo, float hi) {
  unsigned r; asm volatile("v_cvt_pk_bf16_f32 %0, %1, %2" : "=v"(r) : "v"(lo), "v"(hi)); return r;
}
__device__ __forceinline__ float bf2f(unsigned short v) { return __uint_as_float(((unsigned)v) << 16); }
__device__ __forceinline__ float bfs(short v) { return __uint_as_float(((unsigned)(unsigned short)v) << 16); }
__device__ __forceinline__ u32x4 pack8(const float* v) { u32x4 w; w.x = cvtpk(v[0], v[1]); w.y = cvtpk(v[2], v[3]); w.z = cvtpk(v[4], v[5]); w.w = cvtpk(v[6], v[7]); return w; }
__device__ __forceinline__ float swapmax(float v) { auto rr = __builtin_amdgcn_permlane32_swap(__float_as_uint(v), __float_as_uint(v), false, false); return fmaxf(__uint_as_float(rr[0]), __uint_as_float(rr[1])); }
__device__ __forceinline__ float swapsum(float v) { auto rr = __builtin_amdgcn_permlane32_swap(__float_as_uint(v), __float_as_uint(v), false, false); return __uint_as_float(rr[0]) + __uint_as_float(rr[1]); }

template <bool ALIBI>
__device__ __forceinline__ void partialSM(f32x16& p0, f32x16& p1, float& m_reg, float& mn, float& alpha, const float C, const float thr, const float nsl2, const float fb) {
  if constexpr (ALIBI) {
    float fbv = fb; asm volatile("" : "+v"(fbv));
#pragma unroll
    for (int r = 0; r < 16; ++r) { const float cr = (float)((r & 3) + 8 * (r >> 2));
      p0[r] = fmaf(fabsf(fbv - cr), nsl2, p0[r] * C); p1[r] = fmaf(fabsf(fbv - (cr + 32.f)), nsl2, p1[r] * C); }
    float pmax = p0[0];
#pragma unroll
    for (int r = 1; r < 16; ++r) pmax = fmaxf(pmax, p0[r]);
#pragma unroll
    for (int r = 0; r < 16; ++r) pmax = fmaxf(pmax, p1[r]);
    pmax = swapmax(pmax);
    if (__builtin_expect(__all(pmax - m_reg <= thr), 1)) { mn = m_reg; alpha = 1.f; }
    else { mn = fmaxf(m_reg, pmax); alpha = __builtin_amdgcn_exp2f(m_reg - mn); m_reg = mn; }
#pragma unroll
    for (int r = 0; r < 16; ++r) { p0[r] = p0[r] - mn; p1[r] = p1[r] - mn; }
#pragma unroll
    for (int r = 0; r < 16; ++r) p0[r] = __builtin_amdgcn_exp2f(p0[r]);
  } else {
    float pmax = p0[0];
#pragma unroll
    for (int r = 1; r < 16; ++r) pmax = fmaxf(pmax, p0[r]);
#pragma unroll
    for (int r = 0; r < 16; ++r) pmax = fmaxf(pmax, p1[r]);
    pmax = swapmax(pmax);
    if (__builtin_expect(__all(pmax - m_reg <= thr), 1)) { mn = m_reg; alpha = 1.f; }
    else { mn = fmaxf(m_reg, pmax); alpha = __builtin_amdgcn_exp2f((m_reg - mn) * C); m_reg = mn; }
    const float mnC = -mn * C;
#pragma unroll
    for (int r = 0; r < 16; ++r) { p0[r] = fmaf(p0[r], C, mnC); p1[r] = fmaf(p1[r], C, mnC); }
#pragma unroll
    for (int r = 0; r < 16; ++r) p0[r] = __builtin_amdgcn_exp2f(p0[r]);
  }
}
#define PK4(P, BASE, OUT) do { unsigned a0 = cvtpk(P[BASE + 0], P[BASE + 1]), a1 = cvtpk(P[BASE + 2], P[BASE + 3]);   \
    unsigned b0 = cvtpk(P[BASE + 4], P[BASE + 5]), b1 = cvtpk(P[BASE + 6], P[BASE + 7]);                              \
    auto r0 = __builtin_amdgcn_permlane32_swap(a0, b0, false, false); auto r1 = __builtin_amdgcn_permlane32_swap(a1, b1, false, false); \
    u32x4 w = {r0[0], r1[0], r0[1], r1[1]}; OUT = *reinterpret_cast<bf16x8*>(&w); } while (0)
__device__ __forceinline__ void finishSM(f32x16& p0, f32x16& p1, float alpha, float& l_reg, bf16x8& pa0, bf16x8& pa1, bf16x8& pa2, bf16x8& pa3) {
#pragma unroll
  for (int r = 0; r < 16; ++r) p1[r] = __builtin_amdgcn_exp2f(p1[r]);
  float ps = 0;
#pragma unroll
  for (int r = 0; r < 16; ++r) ps += p0[r];
#pragma unroll
  for (int r = 0; r < 16; ++r) ps += p1[r];
  ps = swapsum(ps);
  l_reg = l_reg * alpha + ps;
  PK4(p0, 0, pa0); PK4(p0, 8, pa1); PK4(p1, 0, pa2); PK4(p1, 8, pa3);
}
template <bool ALIBI>
__device__ __forceinline__ void score_init(f32x16& p0, f32x16& p1, const float fb, const float kb, const int rel) {
  if constexpr (!ALIBI) { p0 = f32x16{}; p1 = f32x16{}; }
  else {
    float fbv = fb; asm volatile("" : "+v"(fbv));
    if (rel >= 63) {
      const float A = kb * fbv, B = -kb;
#pragma unroll
      for (int r = 0; r < 16; ++r) { const float cr = (float)((r & 3) + 8 * (r >> 2)); p0[r] = fmaf(cr, B, A); p1[r] = fmaf(cr + 32.f, B, A); }
    } else if (rel <= -31) {
      const float A = -kb * fbv, B = kb;
#pragma unroll
      for (int r = 0; r < 16; ++r) { const float cr = (float)((r & 3) + 8 * (r >> 2)); p0[r] = fmaf(cr, B, A); p1[r] = fmaf(cr + 32.f, B, A); }
    } else {
#pragma unroll
      for (int r = 0; r < 16; ++r) { const float cr = (float)((r & 3) + 8 * (r >> 2)); p0[r] = kb * fabsf(fbv - cr); p1[r] = kb * fabsf(fbv - (cr + 32.f)); }
    }
  }
}
template <int ND>
__device__ __forceinline__ void qkt(f32x16& p0, f32x16& p1, const bf16_t* Ks, const bf16x8* qr, int r32, int hi, int dlo) {
#pragma unroll
  for (int d0 = 0; d0 < ND; ++d0) { int cb = ((dlo + d0) * 16 + hi * 8) * 2;
    bf16x8 b0 = *reinterpret_cast<const bf16x8*>((const char*)Ks + KSWZ(r32, cb));
    bf16x8 b1 = *reinterpret_cast<const bf16x8*>((const char*)Ks + KSWZ(32 + r32, cb));
    p0 = __builtin_amdgcn_mfma_f32_32x32x16_bf16(b0, qr[d0], p0, 0, 0, 0);
    p1 = __builtin_amdgcn_mfma_f32_32x32x16_bf16(b1, qr[d0], p1, 0, 0, 0); }
}
__device__ __forceinline__ int v_st(int k, int c) { const int kk = (k & ~0xC) | ((k & 4) << 1) | ((k & 8) >> 1); return ((kk >> 3) * 4 + (c >> 5)) * 512 + ((kk & 7) * 32 + (c & 31)) * 2; }
__device__ __forceinline__ int v_rd_base(int lane) { return ((lane & 3) << 3) | (((lane >> 2) & 3) << 6) | (((lane >> 4) & 1) << 5) | (((lane >> 5) & 1) << 8); }
constexpr int v_rd_off(int d0, int ks, int half) { return d0 * 512 + ks * 4096 + half * 2048; }
template <int OFF> __device__ __forceinline__ s16x4 tr_read(int vb) {
  s16x4 r; asm volatile("ds_read_b64_tr_b16 %0, %1 offset:%2" : "=&v"(r) : "v"(vb), "i"(OFF) : "memory"); return r;
}
#define PKV(L, H) (bf16x8){L[0], L[1], L[2], L[3], H[0], H[1], H[2], H[3]}
template <int D0> __device__ __forceinline__ void pv_one(f32x16& od, int vb, bf16x8 pa0, bf16x8 pa1, bf16x8 pa2, bf16x8 pa3) {
  const s16x4 l0 = tr_read<v_rd_off(D0, 0, 0)>(vb), h0 = tr_read<v_rd_off(D0, 0, 1)>(vb), l1 = tr_read<v_rd_off(D0, 1, 0)>(vb), h1 = tr_read<v_rd_off(D0, 1, 1)>(vb);
  const s16x4 l2 = tr_read<v_rd_off(D0, 2, 0)>(vb), h2 = tr_read<v_rd_off(D0, 2, 1)>(vb), l3 = tr_read<v_rd_off(D0, 3, 0)>(vb), h3 = tr_read<v_rd_off(D0, 3, 1)>(vb);
  asm volatile("s_waitcnt lgkmcnt(0)" ::: "memory"); SBAR();
  od = __builtin_amdgcn_mfma_f32_32x32x16_bf16(pa0, PKV(l0, h0), od, 0, 0, 0);
  od = __builtin_amdgcn_mfma_f32_32x32x16_bf16(pa1, PKV(l1, h1), od, 0, 0, 0);
  od = __builtin_amdgcn_mfma_f32_32x32x16_bf16(pa2, PKV(l2, h2), od, 0, 0, 0);
  od = __builtin_amdgcn_mfma_f32_32x32x16_bf16(pa3, PKV(l3, h3), od, 0, 0, 0);
}
__device__ __forceinline__ void pv_d0(f32x16* o, int vb, bf16x8 pa0, bf16x8 pa1, bf16x8 pa2, bf16x8 pa3) {
  pv_one<0>(o[0], vb, pa0, pa1, pa2, pa3); pv_one<1>(o[1], vb, pa0, pa1, pa2, pa3); pv_one<2>(o[2], vb, pa0, pa1, pa2, pa3); pv_one<3>(o[3], vb, pa0, pa1, pa2, pa3);
}
template <int D0> __device__ __forceinline__ void pv_one32(f32x16& od, int vb, bf16x8 pa0, bf16x8 pa1) {
  const s16x4 l0 = tr_read<v_rd_off(D0, 0, 0)>(vb), h0 = tr_read<v_rd_off(D0, 0, 1)>(vb), l1 = tr_read<v_rd_off(D0, 1, 0)>(vb), h1 = tr_read<v_rd_off(D0, 1, 1)>(vb);
  asm volatile("s_waitcnt lgkmcnt(0)" ::: "memory"); SBAR();
  od = __builtin_amdgcn_mfma_f32_32x32x16_bf16(pa0, PKV(l0, h0), od, 0, 0, 0);
  od = __builtin_amdgcn_mfma_f32_32x32x16_bf16(pa1, PKV(l1, h1), od, 0, 0, 0);
}

template <int ND, bool ALIBI, int DLO, bool QROPE = false>
__device__ __forceinline__ void attn_core(const bf16_t* __restrict__ Qb, const bf16_t* __restrict__ Kh, const int voff, const int ldq, const int ldk,
                                          const float scale, const float nsl2, const int qpos0, const int seq, char* lds, f32x16 (&o)[4], const float* tab = nullptr  ) {
  int tid = threadIdx.x; asm volatile("" : "+v"(tid));
  constexpr int dlo = DLO;
  const int wid = tid >> 6, lane = tid & 63, r32 = lane & 31, hi = lane >> 5;
  bf16_t* V_lds = (bf16_t*)lds; bf16_t* K_lds = (bf16_t*)(lds + 2 * SHM_V);
  float* ws = (float*)(lds + ATT_WS_OFF) + wid * 64; float* li_l = ws; float* al_l = ws + 32;
  const float C = scale * LOG2E; const float thr = THR / scale; const float kb = nsl2 / C;
  const int qw = __builtin_amdgcn_readfirstlane(qpos0 + wid * QBLK);
  const float fq0 = (float)(qpos0 + wid * QBLK + r32 - 4 * hi);
  float m_reg = -1e30f, l_reg = 0; bf16x8 qr[ND];
#pragma unroll
  for (int d = 0; d < 4; ++d) o[d] = f32x16{};
  const bf16_t* Qw = Qb + (unsigned)((wid * QBLK + r32) * ldq + hi * 8 + dlo * 16);
#pragma unroll
  for (int d0 = 0; d0 < ND; ++d0) qr[d0] = *reinterpret_cast<const bf16x8*>(Qw + d0 * 16);
  if constexpr (QROPE) {
    const float* ropec = tab; const float* ropes = tab + 2048; const float* gq = tab + 4096;
    float xf[8][8]; float ss = 0.f;
#pragma unroll
    for (int d0 = 0; d0 < 8; ++d0)
#pragma unroll
      for (int e = 0; e < 8; ++e) { xf[d0][e] = bfs(qr[d0][e]); ss += xf[d0][e] * xf[d0][e]; }
    ss = swapsum(ss);
    const float rinv = 1.f / sqrtf(ss * (1.f / 128.f) + 1e-6f);
#pragma unroll
    for (int d0 = 0; d0 < 8; ++d0) { const f32x4v g0 = *reinterpret_cast<const f32x4v*>(gq + 16 * d0 + 8 * hi), g1 = *reinterpret_cast<const f32x4v*>(gq + 16 * d0 + 8 * hi + 4);
#pragma unroll
      for (int e = 0; e < 4; ++e) { xf[d0][e] = xf[d0][e] * rinv * g0[e]; xf[d0][4 + e] = xf[d0][4 + e] * rinv * g1[e]; } }
    const int spos = qpos0 + wid * QBLK + r32;
#pragma unroll
    for (int sec = 0; sec < 2; ++sec) { const int id = sec ? (spos & 63) : (spos >> 6);
#pragma unroll
      for (int hf = 0; hf < 2; ++hf) { const int j0 = id * 32 + 16 * hf + 8 * hi; const int da = 4 * sec + hf, db = da + 2;
        const f32x4v c0 = *reinterpret_cast<const f32x4v*>(ropec + j0), c1 = *reinterpret_cast<const f32x4v*>(ropec + j0 + 4);
        const f32x4v s0 = *reinterpret_cast<const f32x4v*>(ropes + j0), s1 = *reinterpret_cast<const f32x4v*>(ropes + j0 + 4);
#pragma unroll
        for (int e = 0; e < 8; ++e) { const float c = (e < 4) ? c0[e & 3] : c1[e & 3], sn = (e < 4) ? s0[e & 3] : s1[e & 3];
          const float x1 = xf[da][e], x2 = xf[db][e]; xf[da][e] = x1 * c - x2 * sn; xf[db][e] = x2 * c + x1 * sn; } } }
#pragma unroll
    for (int d0 = 0; d0 < 8; ++d0) { u32x4 w = pack8(xf[d0]); qr[d0] = *reinterpret_cast<bf16x8*>(&w); }
  }
  const int sr = tid >> 4, sc = (tid & 15) * 8, vst0 = v_st(sr, sc); constexpr int vst1d = 8192;
  const int vb0 = (int)(uintptr_t)V_lds + v_rd_base(lane);
  struct { bf16x8 vs0, vs1, ks0, ks1; } sr_[2];
  const unsigned lo0 = (unsigned)(sr * ldk + sc), lo1 = lo0 + (unsigned)(32 * ldk);
#define SLOAD(i, k0) do { const bf16_t* Kt_ = Kh + (long)(k0) * ldk; const bf16_t* Vt_ = Kt_ + voff; \
    sr_[i].vs0 = *reinterpret_cast<const bf16x8*>(Vt_ + lo0); sr_[i].vs1 = *reinterpret_cast<const bf16x8*>(Vt_ + lo1); \
    sr_[i].ks0 = *reinterpret_cast<const bf16x8*>(Kt_ + lo0); sr_[i].ks1 = *reinterpret_cast<const bf16x8*>(Kt_ + lo1); } while (0)
#define SWRITE(b, i) do { *(bf16x8*)((char*)V_lds + (b) * SHM_V + vst0) = sr_[i].vs0;          \
    *(bf16x8*)((char*)V_lds + (b) * SHM_V + vst0 + vst1d) = sr_[i].vs1; int kc = sc * 2;               \
    *(bf16x8*)((char*)K_lds + (b) * SHM_K + KSWZ(sr, kc)) = sr_[i].ks0;                       \
    *(bf16x8*)((char*)K_lds + (b) * SHM_K + KSWZ(32 + sr, kc)) = sr_[i].ks1; } while (0)
#define SWAIT() asm volatile("s_waitcnt vmcnt(4)" ::: "memory")
#define RESC(a) do { if (__any((a) < 1.f)) { if (hi == 0) al_l[r32] = (a); asm volatile("s_waitcnt lgkmcnt(0)" ::: "memory"); \
    _Pragma("unroll") for (int d = 0; d < 4; ++d) _Pragma("unroll") for (int r = 0; r < 16; ++r) o[d][r] *= al_l[crow(r, hi)]; } } while (0)
  f32x16 pA0, pA1, pB0, pB1; float mnA, mnB, alA, alB; bf16x8 pa0, pa1, pa2, pa3; const int NT = seq / KVBLK;
  constexpr int SE = 0, SO = 1;
  SLOAD(SE, 0); asm volatile("s_waitcnt vmcnt(0)" ::: "memory"); SWRITE(0, SE); __syncthreads();
  score_init<ALIBI>(pA0, pA1, fq0, kb, qw); qkt<ND>(pA0, pA1, K_lds, qr, r32, hi, dlo); partialSM<false>(pA0, pA1, m_reg, mnA, alA, C, thr, 0.f, 0.f);
  SLOAD(SO, KVBLK); if (2 < NT) SLOAD(SE, 2 * KVBLK);
  SWAIT(); SWRITE(1, SO); __syncthreads();
  for (int j = 1; j + 1 < NT; j += 2) {
    SBAR(); score_init<ALIBI>(pB0, pB1, fq0 - (float)(j * KVBLK), kb, qw - j * KVBLK); qkt<ND>(pB0, pB1, (bf16_t*)((char*)K_lds + SHM_K), qr, r32, hi, dlo);
    finishSM(pA0, pA1, alA, l_reg, pa0, pa1, pa2, pa3); SBAR();
    SLOAD(SO, (j + 2) * KVBLK); SBAR();
    pv_d0(o, vb0, pa0, pa1, pa2, pa3); partialSM<false>(pB0, pB1, m_reg, mnB, alB, C, thr, 0.f, 0.f);
    __syncthreads(); SWAIT(); SWRITE(0, SE);
    RESC(alB); __syncthreads();
    SBAR(); score_init<ALIBI>(pA0, pA1, fq0 - (float)((j + 1) * KVBLK), kb, qw - (j + 1) * KVBLK); qkt<ND>(pA0, pA1, K_lds, qr, r32, hi, dlo);
    finishSM(pB0, pB1, alB, l_reg, pa0, pa1, pa2, pa3); SBAR();
    if (j + 3 < NT) SLOAD(SE, (j + 3) * KVBLK); SBAR();
    pv_d0(o, vb0 + (int)SHM_V, pa0, pa1, pa2, pa3); partialSM<false>(pA0, pA1, m_reg, mnA, alA, C, thr, 0.f, 0.f);
    __syncthreads(); SWAIT(); SWRITE(1, SO);
    RESC(alA); __syncthreads();
  }
  SBAR(); score_init<ALIBI>(pB0, pB1, fq0 - (float)((NT - 1) * KVBLK), kb, qw - (NT - 1) * KVBLK); qkt<ND>(pB0, pB1, (bf16_t*)((char*)K_lds + SHM_K), qr, r32, hi, dlo);
  finishSM(pA0, pA1, alA, l_reg, pa0, pa1, pa2, pa3); SBAR();
  pv_d0(o, vb0, pa0, pa1, pa2, pa3); partialSM<false>(pB0, pB1, m_reg, mnB, alB, C, thr, 0.f, 0.f);
  __syncthreads(); RESC(alB);
  finishSM(pB0, pB1, alB, l_reg, pa0, pa1, pa2, pa3); SBAR();
  pv_d0(o, vb0 + (int)SHM_V, pa0, pa1, pa2, pa3);
  if (hi == 0) li_l[r32] = l_reg; asm volatile("s_waitcnt lgkmcnt(0)" ::: "memory");
#pragma unroll
  for (int r = 0; r < 16; ++r) { const float rl = __builtin_amdgcn_rcpf(li_l[crow(r, hi)]);
#pragma unroll
    for (int d0 = 0; d0 < 4; ++d0) o[d0][r] *= rl; }
#undef SLOAD
#undef SWRITE
#undef SWAIT
#undef RESC
}
__device__ __forceinline__ void stage_o(const f32x16 (&o)[4], bf16_t* stg, int r32, int hi) {
  asm volatile("" ::: "memory");
#pragma unroll
  for (int r = 0; r < 16; ++r) { const int row = crow(r, hi);
#pragma unroll
    for (int d0 = 0; d0 < 4; d0 += 1) { const unsigned w = cvtpk(o[d0][r], 0.f); stg[row * STG_PITCH + d0 * 32 + r32] = (bf16_t)(w & 0xffffu); } }
  asm volatile("s_waitcnt lgkmcnt(0)" ::: "memory");
}
__device__ __forceinline__ bf16x8 stage_rd(const bf16_t* stg, int lane, int i) { return *reinterpret_cast<const bf16x8*>(stg + (lane >> 1) * STG_PITCH + (lane & 1) * 64 + i * 8); }
__device__ __forceinline__ float silu(float g) { return g * __builtin_amdgcn_rcpf(1.f + __builtin_amdgcn_exp2f(-g * LOG2E)); }

constexpr long HSTRIDE = 16L * 2048 * 128;
__device__ __forceinline__ const bf16_t* hm(const bf16_t* P, int ch, int b) { return P + ((long)(ch * 16 + b) * 2048) * 128; }
constexpr int SEQ = 2048;
__device__ __forceinline__ void unit_A(int b, int h, int qb, const bf16_t* P1, bf16_t* Y, char* lds, const float* tab) {
  const long tok0 = (long)b * SEQ + qb * 256; const int kvh = h >> 2;
  f32x16 o[4];
  attn_core<8, false, 0, true>(hm(P1, h, b) + (long)qb * 256 * 128, hm(P1, 8 + kvh, b), (int)(2 * HSTRIDE), 128, 128,
                      0.08838834764831845f, 0.f, qb * 256, SEQ, lds, o, tab);
  int tid = threadIdx.x; asm volatile("" : "+v"(tid));
  const int wid = tid >> 6, lane = tid & 63, r32 = lane & 31, hi = lane >> 5;
  bf16_t* stg = (bf16_t*)(lds + ATT_STG_OFF + wid * STG_BYTES);
  const long tok = tok0 + wid * 32 + (lane >> 1); const int ch = (lane & 1) * 64;
  const bf16_t* gp = hm(P1, 36 + h, b) + (long)(qb * 256 + wid * 32 + (lane >> 1)) * 128 + ch; bf16_t* yp = Y + tok * 2048 + h * 128 + ch;
  bf16x8 gv[8];
  asm volatile("" : "+v"(gp));
#pragma unroll
  for (int i = 0; i < 8; ++i) gv[i] = *reinterpret_cast<const bf16x8*>(gp + i * 8);
  stage_o(o, stg, r32, hi);
#pragma unroll
  for (int i = 0; i < 8; ++i) { const bf16x8 ov = stage_rd(stg, lane, i); float v[8];
#pragma unroll
    for (int e = 0; e < 8; ++e) v[e] = bfs(ov[e]) * silu(bfs(gv[i][e]));
    *reinterpret_cast<u32x4*>(yp + i * 8) = pack8(v); }
  asm volatile("s_waitcnt lgkmcnt(0)" ::: "memory");
}
__device__ __forceinline__ void unit_B(int b, int h, int qb, const bf16_t* P1, bf16_t* Y, float* scr  , const float lam,
                                       const float* gsub, char* lds) {
  const long tok0 = (long)b * SEQ + qb * 256;
  const float nsl2 = __uint_as_float(__builtin_amdgcn_readfirstlane(__float_as_uint(-__builtin_amdgcn_exp2f(-(float)(h + 1)) * LOG2E)));
  const bf16_t* Qp = hm(P1, 12 + h, b) + (long)qb * 256 * 128; const bf16_t* Kp = hm(P1, 20 + h, b);
  f32x16 o[4];
  attn_core<4, true, 0>(Qp, Kp, (int)(8 * HSTRIDE), 128, 128, 0.125f, nsl2, qb * 256, SEQ, lds, o);
  { int lane_ = threadIdx.x & 63; asm volatile("" : "+v"(lane_)); float* sp = scr + lane_;
#pragma unroll
  for (int d0 = 0; d0 < 4; ++d0)
#pragma unroll
    for (int r = 0; r < 16; ++r) sp[(d0 * 16 + r) * 64] = o[d0][r]; }
  attn_core<4, true, 4>(Qp, Kp, (int)(8 * HSTRIDE), 128, 128, 0.125f, nsl2, qb * 256, SEQ, lds, o);
  int tid = threadIdx.x; asm volatile("" : "+v"(tid));
  const int wid = tid >> 6, lane = tid & 63, r32 = lane & 31, hi = lane >> 5;
  { const float* sp = scr + lane;
#pragma unroll
  for (int d0 = 0; d0 < 4; ++d0)
#pragma unroll
    for (int r = 0; r < 16; ++r) o[d0][r] = sp[(d0 * 16 + r) * 64] - lam * o[d0][r]; }
  bf16_t* stg = (bf16_t*)(lds + ATT_STG_OFF + wid * STG_BYTES);
  const long tok = tok0 + wid * 32 + (lane >> 1); const int ch = (lane & 1) * 64;
  const bf16_t* gp = hm(P1, 44 + h, b) + (long)(qb * 256 + wid * 32 + (lane >> 1)) * 128 + ch; bf16_t* yp = Y + tok * 2048 + 1024 + h * 128 + ch; const float* gs = gsub + ch;
  bf16x8 gv[8]; f32x4v gsv[16];
  asm volatile("" : "+v"(gp));
#pragma unroll
  for (int i = 0; i < 8; ++i) gv[i] = *reinterpret_cast<const bf16x8*>(gp + i * 8);
  stage_o(o, stg, r32, hi);
#pragma unroll
  for (int i = 0; i < 16; ++i) gsv[i] = *reinterpret_cast<const f32x4v*>(gs + i * 4);
  bf16x8 ov[8]; float ss = 0.f;
#pragma unroll
  for (int i = 0; i < 8; ++i) { ov[i] = stage_rd(stg, lane, i);
#pragma unroll
    for (int e = 0; e < 8; ++e) { const float x = bfs(ov[i][e]); ss += x * x; } }
  ss += __uint_as_float(__builtin_amdgcn_update_dpp(0, __float_as_uint(ss), 0xB1, 0xf, 0xf, true));
  const float rinv = __builtin_amdgcn_rsqf(ss * (1.f / 128.f) + 1e-5f) * 0.8f;
#pragma unroll
  for (int i = 0; i < 8; ++i) { float v[8];
#pragma unroll
    for (int e = 0; e < 8; ++e) v[e] = bfs(ov[i][e]) * rinv * gsv[2 * i + (e >> 2)][e & 3] * silu(bfs(gv[i][e]));
    *reinterpret_cast<u32x4*>(yp + i * 8) = pack8(v); }
  asm volatile("s_waitcnt lgkmcnt(0)" ::: "memory");
}

constexpr int WG_TILE_REGION = 12 * 8192;
#define WBAR() asm volatile("s_waitcnt lgkmcnt(0)\n\ts_barrier" ::: "memory")
template <int R, bool FINAL>
__device__ __forceinline__ void win_seq(const int nu, const int bh0, const int bhstep, const int g, const bf16_t* P3, char* lds,
                                        bf16_t* Op, float* lsep, const bf16_t* O0, const float* lse0, const bf16_t* O1, const float* lse1, bf16_t* Y) {
  constexpr int NBLK = 2048 / R / 32;
  constexpr int NS = (R == 16) ? 8 : 12;
  const int wid = __builtin_amdgcn_readfirstlane(threadIdx.x >> 6);
  const int cls = (R == 1) ? 0 : (R == 4) ? (g >> 1) : (2 * g + (wid >> 2));
  const int n = (R == 1) ? (8 * g + wid) : (R == 4) ? ((g & 1) * 8 + wid) : (wid & 3);
  const int T0 = (R == 16) ? 0 : (((R == 1) ? 8 * g : (g & 1) * 8) - 2);
  float* wsf = (float*)(lds + WG_TILE_REGION) + wid * 64;
  bf16_t* stg = (bf16_t*)(lds + wid * STG_BYTES);
  const float C1 = 0.08838834764831845f * LOG2E;
#define LANEVALS int tid = threadIdx.x; asm volatile("" : "+v"(tid)); const int lane = tid & 63, r32 = lane & 31, hi = lane >> 5; \
    const int lr = tid >> 4, lc8 = (tid & 15) * 8; (void)lane; (void)r32; (void)hi; (void)lr; (void)lc8
#define SLOT_CLASS(s) ((R == 16) ? (2 * g + ((s) >> 2)) : cls)
#define SLOT_TILE(s)  ((R == 16) ? ((s) & 3) : (T0 + (s)))
#define SLOT_OK(s)    ((R == 16) ? true : (SLOT_TILE(s) >= 0 && SLOT_TILE(s) < NBLK))
#define LOAD_TILES(dst, colhead, b_, h_) LOAD_TILES_R(dst, colhead, b_, h_, 0, NS)
#define LOAD_TILES_R(dst, colhead, b_, h_, SLO, SHI) do { LANEVALS; const unsigned ldoff = (unsigned)(lr * R * 128 + lc8); const bf16_t* base_ = hm(P3, (colhead) + (h_), (b_)); \
    _Pragma("unroll") for (int s_ = (SLO); s_ < (SHI); ++s_) { int tl_ = SLOT_TILE(s_); tl_ = __builtin_amdgcn_readfirstlane(tl_ < 0 ? 0 : (tl_ > NBLK - 1 ? NBLK - 1 : tl_));     \
      const bf16_t* sb_ = base_ + (long)(tl_ * 32 * R + SLOT_CLASS(s_)) * 128; dst[s_] = *reinterpret_cast<const bf16x8*>(sb_ + ldoff); } } while (0)
#define LOAD_Q(b_, h_) do { LANEVALS; const unsigned qoff = (unsigned)(r32 * R * 128 + hi * 8); const bf16_t* qb_ = hm(P3, (h_), (b_)) + (long)(32 * n * R + cls) * 128; \
    _Pragma("unroll") for (int d0 = 0; d0 < 8; ++d0) qn[d0] = *reinterpret_cast<const bf16x8*>(qb_ + qoff + d0 * 16); } while (0)
  bf16x8 kst[NS], qn[8];
  LOAD_TILES(kst, 16, bh0 >> 4, bh0 & 15); LOAD_Q(bh0 >> 4, bh0 & 15);
  for (int u = 0; u < nu; ++u) {
    const int bh = bh0 + u * bhstep, b = bh >> 4, h = bh & 15;
    const float C2 = -__builtin_amdgcn_exp2f(-0.5f * (float)(h + 1)) * (float)R * LOG2E;
    WBAR();
    { LANEVALS; const int kst_off = KSWZ(lr, lc8 * 2);
#pragma unroll
    for (int s = 0; s < NS; ++s) *(bf16x8*)(lds + s * 8192 + kst_off) = kst[s]; }
    bf16x8 qr[8];
#pragma unroll
    for (int d0 = 0; d0 < 8; ++d0) qr[d0] = qn[d0];
    bf16x8 vst[NS];
    LOAD_TILES(vst, 32, b, h);
    WBAR();
    LANEVALS;
    const float fb0 = (float)(r32 + 64 - 4 * hi);
    f32x16 p[5];
#pragma unroll
    for (int j = 0; j < 5; ++j) {
      const int tile = n - 2 + j;
      if (tile >= 0 && tile < NBLK) {
        const char* Ks = lds + ((R == 16) ? ((wid >> 2) * 4 + tile) : (wid + j)) * 8192;
        f32x16 acc = f32x16{};
#pragma unroll
        for (int d0 = 0; d0 < 8; ++d0) { const bf16x8 b0 = *reinterpret_cast<const bf16x8*>(Ks + KSWZ(r32, (d0 * 16 + hi * 8) * 2));
          acc = __builtin_amdgcn_mfma_f32_32x32x16_bf16(b0, qr[d0], acc, 0, 0, 0); }
        float fb = fb0 - (float)(32 * j); asm volatile("" : "+v"(fb));
#pragma unroll
        for (int rr = 0; rr < 16; ++rr) { const float d = fabsf(fb - (float)((rr & 3) + 8 * (rr >> 2)));
          const float t = fmaf(d, C2, acc[rr] * C1); acc[rr] = (d <= 64.f) ? t : -INFINITY; }
        p[j] = acc;
      } else {
#pragma unroll
        for (int rr = 0; rr < 16; ++rr) p[j][rr] = -INFINITY;
      }
    }
    float mx = -INFINITY;
#pragma unroll
    for (int j = 0; j < 5; ++j)
#pragma unroll
      for (int rr = 0; rr < 16; ++rr) mx = fmaxf(mx, p[j][rr]);
    mx = swapmax(mx);
    float ls = 0.f;
#pragma unroll
    for (int j = 0; j < 5; ++j)
#pragma unroll
      for (int rr = 0; rr < 16; ++rr) { p[j][rr] = __builtin_amdgcn_exp2f(p[j][rr] - mx); ls += p[j][rr]; }
    ls = swapsum(ls);
    bf16x8 pa[5][2];
#pragma unroll
    for (int j = 0; j < 5; ++j) { PK4(p[j], 0, pa[j][0]); PK4(p[j], 8, pa[j][1]); }
    WBAR();
    { const int vst_off = v_st(lr, lc8);
#pragma unroll
    for (int s = 0; s < NS; ++s) *(bf16x8*)(lds + s * 8192 + vst_off) = vst[s]; }
    const int vb0 = (int)(uintptr_t)lds + v_rd_base(lane);
    if (!FINAL && u + 1 < nu) { const int nbh = bh + bhstep; LOAD_TILES_R(kst, 16, nbh >> 4, nbh & 15, 0, NS / 2); }
    WBAR();
    f32x16 o[4];
#pragma unroll
    for (int d = 0; d < 4; ++d) o[d] = f32x16{};
#pragma unroll
    for (int j = 0; j < 5; ++j) {
      const int tile = n - 2 + j;
      if (tile >= 0 && tile < NBLK) {
        const int vb = vb0 + ((R == 16) ? ((wid >> 2) * 4 + tile) : (wid + j)) * 8192;
        pv_one32<0>(o[0], vb, pa[j][0], pa[j][1]); pv_one32<1>(o[1], vb, pa[j][0], pa[j][1]); pv_one32<2>(o[2], vb, pa[j][0], pa[j][1]); pv_one32<3>(o[3], vb, pa[j][0], pa[j][1]);
      }
    }
    if (!FINAL && u + 1 < nu) { const int nbh = bh + bhstep; LOAD_TILES_R(kst, 16, nbh >> 4, nbh & 15, NS / 2, NS); LOAD_Q(nbh >> 4, nbh & 15); }
    const int row = lane >> 1, ch = (lane & 1) * 64;
    const int tseq = (32 * n + row) * R + cls; const long tok = (long)b * SEQ + tseq; const long hrow = ((long)(b * 16 + h) * 2048 + tseq);
    bf16x8 x0v[8], x1v[8], gtv[8]; float a0 = 0.f, a1 = 0.f;
    if constexpr (FINAL) {
      a0 = lse0[hrow]; a1 = lse1[hrow];
      const bf16_t* p0 = O0 + hrow * 128 + ch; const bf16_t* p1 = O1 + hrow * 128 + ch; const bf16_t* gp = hm(P3, 48 + h, b) + (long)tseq * 128 + ch;
#pragma unroll
      for (int i = 0; i < 8; ++i) { x0v[i] = *reinterpret_cast<const bf16x8*>(p0 + i * 8); x1v[i] = *reinterpret_cast<const bf16x8*>(p1 + i * 8); gtv[i] = *reinterpret_cast<const bf16x8*>(gp + i * 8); }
    }
    const float lse2 = mx + __builtin_amdgcn_logf(ls);
    if (hi == 0) { wsf[r32] = ls; wsf[32 + r32] = lse2; } asm volatile("s_waitcnt lgkmcnt(0)" ::: "memory");
#pragma unroll
    for (int rr = 0; rr < 16; ++rr) { const float rl = __builtin_amdgcn_rcpf(wsf[crow(rr, hi)]);
#pragma unroll
      for (int d = 0; d < 4; ++d) o[d][rr] *= rl; }
    const float mylse = wsf[32 + row];
    WBAR();
    stage_o(o, stg, r32, hi);
    if constexpr (!FINAL) {
      bf16_t* op = Op + hrow * 128 + ch;
#pragma unroll
      for (int i = 0; i < 8; ++i) *reinterpret_cast<bf16x8*>(op + i * 8) = stage_rd(stg, lane, i);
      if ((lane & 1) == 0) lsep[hrow] = mylse;
    } else {
      const float mxl = fmaxf(fmaxf(a0, a1), mylse);
      float w0 = __builtin_amdgcn_exp2f(a0 - mxl), w1 = __builtin_amdgcn_exp2f(a1 - mxl), w2 = __builtin_amdgcn_exp2f(mylse - mxl);
      const float rden = __builtin_amdgcn_rcpf(w0 + w1 + w2); w0 *= rden; w1 *= rden; w2 *= rden;
      bf16_t* yp = Y + tok * 2048 + h * 128 + ch;
#pragma unroll
      for (int i = 0; i < 8; ++i) { const bf16x8 ov = stage_rd(stg, lane, i); float v[8];
#pragma unroll
        for (int e = 0; e < 8; ++e) v[e] = (w0 * bfs(x0v[i][e]) + w1 * bfs(x1v[i][e]) + w2 * bfs(ov[e])) * silu(bfs(gtv[i][e]));
        *reinterpret_cast<u32x4*>(yp + i * 8) = pack8(v); }
      if (u + 1 < nu) { const int nbh = bh + bhstep; LOAD_TILES(kst, 16, nbh >> 4, nbh & 15); LOAD_Q(nbh >> 4, nbh & 15); }
    }
    asm volatile("s_waitcnt lgkmcnt(0)" ::: "memory");
  }
  WBAR();
#undef SLOT_CLASS
#undef SLOT_TILE
#undef SLOT_OK
#undef LOAD_TILES
#undef LOAD_TILES_R
#undef LANEVALS
#undef LOAD_Q
}
#undef PK4
#undef PKV
#undef KSWZ
#undef SBAR
}
#define LAS __attribute__((address_space(3)))
typedef unsigned short bf16;
typedef unsigned v4u __attribute__((ext_vector_type(4)));
typedef float f32x4 __attribute__((ext_vector_type(4)));
constexpr int NWAVES = 8;
constexpr int T = 32768, SEQ = 2048, DM = 2048, N1 = 6656, N3 = 8192;
constexpr float NORM_EPS = 1e-6f;
constexpr size_t MiB = 1u << 20;
constexpr size_t WS_CTL = 0, CTL_ZERO_BYTES = 1 * MiB;
constexpr size_t WS_W1 = 2 * MiB, WS_W2 = 28 * MiB, WS_W3 = 36 * MiB, WS_W4 = 68 * MiB;
constexpr size_t WS_U = 76 * MiB;
constexpr size_t WS_Y = 204 * MiB;
constexpr size_t WS_O2 = 332 * MiB;
constexpr size_t WS_P = 460 * MiB;
constexpr size_t WS_LSE = 980 * MiB;
constexpr size_t WS_END = 984 * MiB;
constexpr int LDS_BYTES = 147456;
static_assert(att::ATT_LDS_BYTES <= 131072 + 8192 && att::WG_TILE_REGION + 8 * 256 <= LDS_BYTES - 64 && att::ATT_LDS_BYTES <= LDS_BYTES - 64, "LDS map");

__device__ __forceinline__ unsigned f2bf(float f) { unsigned u = __builtin_bit_cast(unsigned, f); return (u + 0x7fffu + ((u >> 16) & 1u)) >> 16; }
__device__ __forceinline__ unsigned pk2(float lo, float hi) { return f2bf(lo) | (f2bf(hi) << 16); }
__device__ __forceinline__ float bf2f(unsigned short v) { return __uint_as_float(((unsigned)v) << 16); }
__device__ __forceinline__ float wave_sum(float v) {
#pragma unroll
    for (int o = 1; o < 64; o <<= 1) v += __shfl_xor(v, o);
    return v;
}
__device__ __forceinline__ void p0_transpose_item(const float* W, int K, int N, bf16* WT, LAS float* scr, int item, int lane) {
    const int nblk = N / 32, kb = item / nblk, nb = item % nblk, k0 = 64 * kb, n0 = 32 * nb;
#pragma unroll 8
    for (int i = 0; i < 32; ++i) { const int kk = 2 * i + (lane >> 5); scr[kk * 33 + (lane & 31)] = W[(size_t)(k0 + kk) * N + n0 + (lane & 31)]; }
    asm volatile("s_waitcnt lgkmcnt(0)" ::: "memory");
    const int c = lane & 7;
#pragma unroll
    for (int j = 0; j < 4; ++j) { const int n = (lane >> 3) + 8 * j; const LAS float* s = scr + (8 * c) * 33 + n;
        v4u o; o.x = pk2(s[0 * 33], s[1 * 33]); o.y = pk2(s[2 * 33], s[3 * 33]); o.z = pk2(s[4 * 33], s[5 * 33]); o.w = pk2(s[6 * 33], s[7 * 33]);
        *(v4u*)(WT + (size_t)(n0 + n) * K + k0 + 8 * c) = o; }
    asm volatile("s_waitcnt lgkmcnt(0)" ::: "memory");
}
__device__ __forceinline__ void rms_row_to_bf16(const float* xrow, const float* g, bf16* orow, int lane, float* rms_out) {
    const f32x4* xr = (const f32x4*)xrow + lane; const f32x4* gr = (const f32x4*)g + lane;
    f32x4 v[8]; float s = 0.f;
#pragma unroll
    for (int j = 0; j < 8; ++j) { v[j] = xr[64 * j]; s += (v[j].x * v[j].x + v[j].y * v[j].y) + (v[j].z * v[j].z + v[j].w * v[j].w); }
    const float rms = sqrtf(wave_sum(s) * (1.f / DM) + NORM_EPS); const float rstd = 1.f / rms;
    if (lane == 0) *rms_out = rms;
    unsigned long long* o8 = (unsigned long long*)orow + lane;
#pragma unroll
    for (int j = 0; j < 8; ++j) { const f32x4 gg = gr[64 * j];
        o8[64 * j] = (unsigned long long)pk2(v[j].x * rstd * gg.x, v[j].y * rstd * gg.y) | ((unsigned long long)pk2(v[j].z * rstd * gg.z, v[j].w * rstd * gg.w) << 32); }
}

#define RLX_AGENT __ATOMIC_RELAXED, __HIP_MEMORY_SCOPE_AGENT
#define XB_TMO      128
#define XB_XCNT(j)  (256  + 64 * (j))
#define XB_XSUB(j)  (1280 + 64 * (j))
#define XB_XGEN(j)  (2304 + 64 * (j))
#define XB_TOP      3328
#define XB_TOPGEN   3392
#define XCD_BAR_WORDS 3456
#define XB_SPIN_CAP (1u << 18)

__device__ __forceinline__ unsigned xb_ld(unsigned* p)              { return __hip_atomic_load(p, __ATOMIC_RELAXED, __HIP_MEMORY_SCOPE_AGENT); }
__device__ __forceinline__ unsigned xb_add(unsigned* p, unsigned v) { return __hip_atomic_fetch_add(p, v, __ATOMIC_RELAXED, __HIP_MEMORY_SCOPE_AGENT); }
__device__ __forceinline__ unsigned xb_xcc_id() { return (unsigned)__builtin_amdgcn_s_getreg((3 << 11) | 20) & 0xFu; }
#define XB_SPIN(cond, bar) do { unsigned _sp = 0; while (cond) { __builtin_amdgcn_s_sleep(1); \
    if ((++_sp & 255u) == 0u) { if (xb_ld(&(bar)[XB_TMO])) break; if (_sp > XB_SPIN_CAP) { atomicAdd(&(bar)[XB_TMO], 1u); break; } } } } while (0)

struct XcdBarrier {
    unsigned* bar; unsigned x;
    volatile LAS unsigned* st;
};

__device__ __forceinline__ XcdBarrier xcd_barrier_post(unsigned* bar, volatile LAS unsigned* st) {
    XcdBarrier b; b.bar = bar; b.x = xb_xcc_id(); b.st = st;
    if (threadIdx.x == 0) (void)xb_add(&bar[XB_XCNT(b.x)], 1u);
    return b;
}
__device__ __forceinline__ void xcd_barrier_complete(unsigned* bar, unsigned x, unsigned& nloc, unsigned& nx) {
    const unsigned G = gridDim.x * gridDim.y * gridDim.z;
    unsigned sum, cnt, mine, sp = 0u;
    for (;;) {
        sum = 0u; cnt = 0u; mine = 0u;
#pragma unroll
        for (unsigned j = 0; j < 16; ++j) { const unsigned c = xb_ld(&bar[XB_XCNT(j)]); sum += c; cnt += (c > 0u) ? 1u : 0u; mine = (j == x) ? c : mine; }
        if (sum == G) break;
        __builtin_amdgcn_s_sleep(1);
        if ((++sp & 255u) == 0u) { if (xb_ld(&bar[XB_TMO])) break; if (sp > XB_SPIN_CAP) { atomicAdd(&bar[XB_TMO], 1u); break; } }
    }
    nloc = mine > 0u ? mine : 1u; nx = cnt > 0u ? cnt : 1u;
}

__device__ __forceinline__ void xcd_barrier(const XcdBarrier& b) {
    asm volatile("s_waitcnt vmcnt(0)" ::: "memory");
    __syncthreads();
    if (threadIdx.x == 0) {
        unsigned* bar = b.bar;
        __builtin_amdgcn_s_waitcnt(0);
        unsigned nloc = b.st[0], nx = b.st[1];
        if (nloc == 0u) { xcd_barrier_complete(bar, b.x, nloc, nx); b.st[0] = nloc; b.st[1] = nx; }
        const unsigned old = xb_add(&bar[XB_XSUB(b.x)], 1u);
        const unsigned gen = old / nloc;
        if (old + 1u == (gen + 1u) * nloc) {
            __builtin_amdgcn_fence(__ATOMIC_RELEASE, "agent");
            asm volatile("s_waitcnt vmcnt(0)" ::: "memory");
            const unsigned og = xb_add(&bar[XB_TOP], 1u);
            const unsigned tg = og / nx;
            if (og + 1u == (tg + 1u) * nx) xb_add(&bar[XB_TOPGEN], 1u);
            else XB_SPIN(xb_ld(&bar[XB_TOPGEN]) == tg, bar);
            __builtin_amdgcn_fence(__ATOMIC_ACQUIRE, "agent");
            xb_add(&bar[XB_XGEN(b.x)], 1u);
            asm volatile("s_waitcnt vmcnt(0)" ::: "memory");
        } else {
            XB_SPIN(xb_ld(&bar[XB_XGEN(b.x)]) == gen, bar);
            __builtin_amdgcn_fence(__ATOMIC_ACQUIRE, "agent");
            asm volatile("s_waitcnt vmcnt(0)" ::: "memory");
        }
    }
    __syncthreads();
}
struct Args { const float* in[15]; float* out; unsigned char* ws; int ph_lo, ph_hi; };
constexpr int NPHASE = 10;
__global__ void __launch_bounds__(NWAVES * 64, 2) fwd_mega(Args args) {
    extern __shared__ __attribute__((aligned(16))) unsigned char lds[];
    cg::grid_group grid = cg::this_grid();
    const int wave = __builtin_amdgcn_readfirstlane(threadIdx.x >> 6);
#define LANE_INIT int tid = threadIdx.x; asm volatile("" : "+v"(tid)); const int lane = tid & 63; (void)lane
    const int G = gridDim.x; const int bx = blockIdx.x; const int vcu = (G % 8 == 0) ? (bx % 8) * (G / 8) + bx / 8 : bx;
    const int gw = vcu * NWAVES + wave, NGW = G * NWAVES;
    unsigned char* ws = args.ws;
    float* rowss1 = (float*)(ws + WS_CTL); float* rowss2 = (float*)(ws + WS_CTL + 131072);
    float* ropec = (float*)(ws + WS_CTL + 262144); float* ropes = ropec + 2048;
    float* rms0 = (float*)(ws + WS_CTL + 655360);
    bf16* W1t = (bf16*)(ws + WS_W1); bf16* W2t = (bf16*)(ws + WS_W2); bf16* W3t = (bf16*)(ws + WS_W3); bf16* W4t = (bf16*)(ws + WS_W4);
    bf16* U = (bf16*)(ws + WS_U); bf16* Y = (bf16*)(ws + WS_Y); bf16* P = (bf16*)(ws + WS_P);
    bf16* O2 = (bf16*)(ws + WS_O2); float* LSE = (float*)(ws + WS_LSE);
    const float* x = args.in[0]; float* out = args.out;
    const int lo = args.ph_lo, hi = args.ph_hi;
#ifndef PH_MASK
#define PH_MASK 0x3ff
#endif
#define IN(k) (((PH_MASK >> (k)) & 1) && lo <= (k) && (k) < hi)
    volatile LAS unsigned* bst = (volatile LAS unsigned*)((LAS unsigned char*)lds + LDS_BYTES - 64);
    if (threadIdx.x < 16) bst[threadIdx.x] = 0u;
    __syncthreads();
    XcdBarrier xbar = xcd_barrier_post((unsigned*)(ws + WS_CTL + 524288), bst);
#define SEAM(k) do { if (IN(k) && IN((k) + 1)) { if ((k) == 0) grid.sync(); else xcd_barrier(xbar); } } while (0)
    LAS unsigned char* ldsl = (LAS unsigned char*)lds;

    if (IN(0)) {
        LANE_INIT;
        LAS float* scr = (LAS float*)(ldsl + wave * 16384);
        constexpr int I1 = (DM / 64) * (N1 / 32), I2 = (DM / 64) * (DM / 32), I3 = (DM / 64) * (N3 / 32), I4 = I2;
        constexpr int NITEMS = I1 + I2 + I3 + I4;
        for (int it = gw; it < NITEMS; it += NGW) {
            int r = it;
            if (r < I1) { p0_transpose_item(args.in[2], DM, N1, W1t, scr, r, lane); continue; } r -= I1;
            if (r < I2) { p0_transpose_item(args.in[10], DM, DM, W2t, scr, r, lane); continue; } r -= I2;
            if (r < I3) { p0_transpose_item(args.in[12], DM, N3, W3t, scr, r, lane); continue; } r -= I3;
            p0_transpose_item(args.in[13], DM, DM, W4t, scr, r, lane);
        }
        for (int m = gw; m < T; m += NGW) rms_row_to_bf16(x + (size_t)m * DM, args.in[1], U + (size_t)m * DM, lane, rms0 + m);
        if (tid < 8 && bx * 8 + tid < 2048) { const int i = bx * 8 + tid; const int id = i >> 5, j = i & 31;
            const float invf = powf(10000.0f, -(float)j / 32.0f); const float ang = (float)id * invf; ropec[i] = cosf(ang); ropes[i] = sinf(ang);
            if (i < 128) ropec[4096 + i] = args.in[3][i]; }
    }
    SEAM(0);
    if (IN(1)) {
        pg8::Gemm g{U, W1t, T, N1, DM}; pg8::StaticOrder S; S.init(T, N1, G, bx);
        pg8::EpiBf16RS E{P, N1, nullptr, 0.f, 0.f};
        pg8::gemm_phase<pg8::EpiBf16RS, pg8::StaticOrder, true, true>(ldsl, g, S, E);
    }
    SEAM(1);
    if (IN(2)) {
        LANE_INIT;
        const float* gq = args.in[3]; const float* gk = args.in[4];
        typedef short bf16x8 __attribute__((ext_vector_type(8)));
        const int hs = lane >> 4, c = lane & 15, cs = c & 7, sec = c >> 3, j0 = (cs & 3) * 8;
#pragma unroll 2
        for (int grp = gw; grp < T * 2 / 4; grp += NGW) {
            const int it = grp * 4 + hs; const int tok = it >> 1, hh = 8 + (it & 1);
            bf16* p = P + ((size_t)(hh * 16 + (tok >> 11)) * 2048 + (tok & 2047)) * 128 + c * 8;
            const bf16x8 v = *(const bf16x8*)p;
            const float* gg = ((hh < 8) ? gq : gk) + c * 8;
            const f32x4 g0 = *(const f32x4*)gg, g1 = *(const f32x4*)(gg + 4);
            const int s = tok & (SEQ - 1); const int id = sec ? (s & 63) : (s >> 6);
            const f32x4 c0 = *(const f32x4*)(ropec + id * 32 + j0), c1 = *(const f32x4*)(ropec + id * 32 + j0 + 4);
            const f32x4 s0 = *(const f32x4*)(ropes + id * 32 + j0), s1 = *(const f32x4*)(ropes + id * 32 + j0 + 4);
            float xv[8]; float ss = 0.f;
#pragma unroll
            for (int e = 0; e < 8; ++e) { xv[e] = bf2f((unsigned short)v[e]); ss += xv[e] * xv[e]; }
            ss += __shfl_xor(ss, 1); ss += __shfl_xor(ss, 2); ss += __shfl_xor(ss, 4); ss += __shfl_xor(ss, 8);
            const float rinv = 1.f / sqrtf(ss * (1.f / 128.f) + NORM_EPS);
            const float gv[8] = {g0.x, g0.y, g0.z, g0.w, g1.x, g1.y, g1.z, g1.w};
            const float cv[8] = {c0.x, c0.y, c0.z, c0.w, c1.x, c1.y, c1.z, c1.w};
            const float sv[8] = {s0.x, s0.y, s0.z, s0.w, s1.x, s1.y, s1.z, s1.w};
            float ov[8];
#pragma unroll
            for (int e = 0; e < 8; ++e) { xv[e] = xv[e] * rinv * gv[e]; }
#pragma unroll
            for (int e = 0; e < 8; ++e) { const float px = __shfl_xor(xv[e], 4); ov[e] = (cs < 4) ? (xv[e] * cv[e] - px * sv[e]) : (xv[e] * cv[e] + px * sv[e]); }
            v4u w; w.x = pk2(ov[0], ov[1]); w.y = pk2(ov[2], ov[3]); w.z = pk2(ov[4], ov[5]); w.w = pk2(ov[6], ov[7]);
            *(v4u*)p = w;
        }
    }
    SEAM(2);
    if (IN(3)) {
        float lam;
        { LANE_INIT; const float a = args.in[5][lane] * args.in[6][lane], c = args.in[7][lane] * args.in[8][lane];
          lam = expf(wave_sum(a)) - expf(wave_sum(c)) + 0.2f; lam = __uint_as_float(__builtin_amdgcn_readfirstlane(__float_as_uint(lam))); }
        float* scrB = (float*)(ws + WS_O2) + (size_t)(vcu * NWAVES + wave) * 4096;
        const int xq = vcu >> 5, lc = vcu & 31;
        for (int i = 0; i < 4; ++i) { const int ua = xq * 128 + i * 32 + lc; att::unit_A(ua >> 6, (ua >> 3) & 7, ua & 7, P, Y, (char*)lds, ropec); }
        for (int i = 0; i < 4; ++i) { const int ub = xq * 128 + i * 32 + lc; att::unit_B(ub >> 6, (ub >> 3) & 7, ub & 7, P, Y, scrB, lam, args.in[9], (char*)lds); }
        __syncthreads();
    }
    SEAM(3);
    if (IN(4)) {
        pg8::Gemm g{Y, W2t, T, DM, DM}; pg8::StaticOrder S; S.init(T, DM, G, bx);
        pg8::EpiResidA E{U, args.in[1], rms0, args.in[11], rowss1, DM};
        pg8::gemm_phase<pg8::EpiResidA, pg8::StaticOrder, true, true>(ldsl, g, S, E);
    }
    SEAM(4);
    if (IN(5)) {
        pg8::Gemm g{U, W3t, T, N3, DM}; pg8::StaticOrder S; S.init(T, N3, G, bx);
        pg8::EpiBf16RS E{P, N3, rowss1, 1.f / DM, NORM_EPS};
        pg8::gemm_phase<pg8::EpiBf16RS, pg8::StaticOrder, true, true>(ldsl, g, S, E);
    }
    SEAM(5);
    if (IN(6)) {
        const int xq = vcu >> 5, lc = vcu & 31;
        if (((lc >> 3) & 1) == 0) att::win_seq<1, false>(16, xq * 32 + (lc >> 4), 2, lc & 7, P, (char*)lds, (bf16*)out, LSE, nullptr, nullptr, nullptr, nullptr, nullptr);
        else                      att::win_seq<4, false>(16, xq * 32 + (lc >> 4), 2, lc & 7, P, (char*)lds, O2, LSE + (size_t)T * 16, nullptr, nullptr, nullptr, nullptr, nullptr);
    }
    SEAM(6);
    if (IN(7)) {
        const int xq = vcu >> 5, lc = vcu & 31;
        att::win_seq<16, true>(8, xq * 32 + 31 - (lc >> 3), -4, lc & 7, P, (char*)lds, nullptr, nullptr, (const bf16*)out, LSE, O2, LSE + (size_t)T * 16, Y);
    }
    SEAM(7);
    if (IN(8)) {
        pg8::Gemm g{Y, W4t, T, DM, DM}; pg8::StaticOrder S; S.init(T, DM, G, bx);
        pg8::EpiResidB E{U, args.in[11], rowss2, DM};
        pg8::gemm_phase<pg8::EpiResidB, pg8::StaticOrder, true, true>(ldsl, g, S, E);
    }
    SEAM(8);
    if (IN(9)) {
        LANE_INIT;
        const f32x4* gr = (const f32x4*)args.in[14];
        for (int m = gw; m < T; m += NGW) {
            const float rs = 1.f / sqrtf(rowss2[m] * (1.f / DM) + NORM_EPS);
            const v4u* hp = (const v4u*)(U + (size_t)m * DM) + lane;
            f32x4* o = (f32x4*)(out + (size_t)m * DM);
#pragma unroll
            for (int j = 0; j < 4; ++j) { const v4u hw = hp[64 * j]; const int c4 = 2 * lane + 128 * j;
                const f32x4 g0 = gr[c4], g1 = gr[c4 + 1];
                f32x4 v0 = (f32x4){__uint_as_float(hw.x << 16), __uint_as_float(hw.x & 0xffff0000u), __uint_as_float(hw.y << 16), __uint_as_float(hw.y & 0xffff0000u)};
                f32x4 v1 = (f32x4){__uint_as_float(hw.z << 16), __uint_as_float(hw.z & 0xffff0000u), __uint_as_float(hw.w << 16), __uint_as_float(hw.w & 0xffff0000u)};
                o[c4] = v0 * rs * g0; o[c4 + 1] = v1 * rs * g1; }
        }
    }
#undef IN
#undef SEAM
}

#ifndef MK_N_LAUNCHES
#define MK_N_LAUNCHES 1
#endif
extern "C" void kernel_launch(void* const* d_in, const int* in_sizes, int n_in, void* d_out, int out_size, void* d_ws, size_t ws_size, hipStream_t stream) {
    static int grid = 0;
    if (grid == 0) {
        if (n_in != 15 || in_sizes[0] != T * DM || out_size != T * DM || ws_size < WS_END) {
            fprintf(stderr, "kernel_launch: unexpected shapes: n_in %d in0 %d out %d ws %zu (need %zu)\n", n_in, n_in > 0 ? in_sizes[0] : -1, out_size, ws_size, (size_t)WS_END); grid = -1; return; }
        int dev = 0, cus = 0, per_cu = 0;
        hipGetDevice(&dev); hipDeviceGetAttribute(&cus, hipDeviceAttributeMultiprocessorCount, dev);
        if (hipFuncSetAttribute((const void*)fwd_mega, hipFuncAttributeMaxDynamicSharedMemorySize, LDS_BYTES) != hipSuccess) { fprintf(stderr, "kernel_launch: hipFuncSetAttribute failed\n"); grid = -1; return; }
        if (hipOccupancyMaxActiveBlocksPerMultiprocessor(&per_cu, (const void*)fwd_mega, NWAVES * 64, LDS_BYTES) != hipSuccess || per_cu < 1) { fprintf(stderr, "kernel_launch: occupancy query says %d\n", per_cu); per_cu = 1; }
        (void)hipGetLastError();
        grid = 256;
        if (cus < 256) { fprintf(stderr, "kernel_launch: %d CUs < 256: cannot co-schedule the grid\n", cus); grid = -1; return; }
        if (grid != 256) fprintf(stderr, "kernel_launch: note: %d CUs (phase schedules assume 256)\n", grid);
    }
    if (grid < 0) return;
    hipMemsetAsync((char*)d_ws + WS_CTL, 0, CTL_ZERO_BYTES, stream);
    Args a{};
    for (int i = 0; i < 15; ++i) a.in[i] = (const float*)d_in[i];
    a.out = (float*)d_out; a.ws = (unsigned char*)d_ws;
#if MK_N_LAUNCHES == 1
    a.ph_lo = 0; a.ph_hi = NPHASE;
    void* kargs[] = {&a};
    hipError_t e = hipLaunchCooperativeKernel((const void*)fwd_mega, dim3(grid), dim3(NWAVES * 64), kargs, LDS_BYTES, stream);
    if (e != hipSuccess) fprintf(stderr, "kernel_launch: cooperative launch failed: %s (grid %d)\n", hipGetErrorString(e), grid);
#else
    for (int p = 0; p < NPHASE; ++p) { a.ph_lo = p; a.ph_hi = p + 1; hipLaunchKernelGGL(fwd_mega, dim3(grid), dim3(NWAVES * 64), LDS_BYTES, stream, a); }
#endif
}
```

```cpp
#include <hip/hip_runtime.h>
#include <hip/hip_cooperative_groups.h>
#include <cstdio>
#include <cstdint>
namespace cg = cooperative_groups;
namespace pg8 {
#define PG8_LAS __attribute__((address_space(3)))
typedef unsigned short bf16_t;
typedef short bf16x8 __attribute__((ext_vector_type(8)));
typedef float f32x4 __attribute__((ext_vector_type(4)));
typedef unsigned u32x4 __attribute__((ext_vector_type(4)));
constexpr int BM = 256, BK = 64, HALF = 128, HTB = HALF * BK * 2  , STAGE_BYTES = 8 * HTB, NXCD = 8, WGM = 8;

__host__ __device__ __forceinline__ int lds_byte(int r, int c) { const int st = (r >> 4) * 2 + (c >> 5), rr = r & 15, cc = c & 31, ob = rr * 64 + cc * 2; return st * 1024 + (ob ^ (((ob >> 9) & 1) << 5)); }
__host__ __device__ __forceinline__ void stage_rc(int b, int& R, int& C) { const int st = b / 1024, sb = b % 1024, swz = sb ^ (((sb >> 9) & 1) << 5); R = (st >> 1) * 16 + swz / 64; C = (st & 1) * 32 + (swz % 64) / 2; }
__host__ __device__ __forceinline__ int perm32(int rho) { const int n = rho >> 4, i = rho & 15; return 8 * (i >> 2) + 4 * n + (i & 3); }

struct Unit { int pm, pn; };
struct Gemm { const bf16_t* A; const bf16_t* Bt; int M, N, K; };

struct StaticOrder {
    int nM, nN, nwg, G, c;
    __host__ __device__ void init(int M, int N, int G_, int c_) { nM = M / BM; nN = N / BM; nwg = nM * nN; G = G_; c = c_; }
    __host__ __device__ bool next(int i, Unit& u) const {
        const long L = (long)i * G + c; if (L >= nwg) return false;
        int wgid = (int)L; { const int q = nwg / NXCD, r = nwg % NXCD, xcd = wgid % NXCD, off = wgid / NXCD; wgid = (xcd < r ? xcd * (q + 1) : r * (q + 1) + (xcd - r) * q) + off; }
        const int nig = WGM * nN, gid = wgid / nig, fm = gid * WGM, gsz = (nM - fm) < WGM ? (nM - fm) : WGM;
        u.pm = fm + ((wgid % nig) % gsz); u.pn = (wgid % nig) / gsz; return true;
    }
    __device__ __forceinline__ void a_ready(const Unit&) const {}
    __device__ __forceinline__ void done(const Unit&) const {}
};

__device__ __forceinline__ unsigned cvt_pk_bf16(float lo, float hi) { unsigned r; asm volatile("v_cvt_pk_bf16_f32 %0, %1, %2" : "=v"(r) : "v"(lo), "v"(hi)); return r; }
typedef float f32x2 __attribute__((ext_vector_type(2)));
__device__ __forceinline__ f32x2 gelu_pk(f32x2 v) {
    const f32x2 av = __builtin_elementwise_abs(v), d = av * 0.2316418882f + 1.0f;
    f32x2 t; t.x = __builtin_amdgcn_rcpf(d.x); t.y = __builtin_amdgcn_rcpf(d.y);
    f32x2 q = t * 0.5307027145f + (-0.7265760135f); q = q * t + 0.7107068705f; q = q * t + (-0.142248368f); q = q * t + 0.127414796f; q = q * t;
    const f32x2 s = (v * v) * (-0.72134752044f);
    f32x2 e; e.x = __builtin_amdgcn_exp2f(s.x); e.y = __builtin_amdgcn_exp2f(s.y);
    const f32x2 m = v * (q * e), r = v - m;
    f32x2 o; o.x = v.x < 0.f ? m.x : r.x; o.y = v.y < 0.f ? m.y : r.y; return o;
}

template <int ACT  > struct EpiBf16 {
    static constexpr bool PERM = true, AFTER_DRAIN = false; static_assert(ACT == 0 || ACT == 1, "EpiBf16: ACT is 0 (none) or 1 (gelu_pk)");
    bf16_t* O; int ldc; const float* bias; int split_cols; size_t split_stride; float scale0;
    __device__ __forceinline__ void operator()(const f32x4 (&acc)[2][2][4][2], const Unit& u, int wr, int wc, int fr, int fq) const {
        const int row0 = u.pm * BM + wr * 64 + fr; int colt = u.pn * BM; bf16_t* base = O;
        float sc = 1.f; if (split_cols) { const int t = colt / split_cols; base += (size_t)t * split_stride; colt -= t * split_cols; if (t == 0) sc = scale0; }
        const int col0 = colt + wc * 32 + 8 * fq, bcol0 = u.pn * BM + wc * 32 + 8 * fq;
        f32x4 bv[2][2];
#pragma unroll
        for (int bj = 0; bj < 2; ++bj)
#pragma unroll
            for (int n = 0; n < 2; ++n) bv[bj][n] = bias ? *(const f32x4*)(bias + bcol0 + bj * HALF + 4 * n) : (f32x4){0.f, 0.f, 0.f, 0.f};
#pragma unroll
        for (int ai = 0; ai < 2; ++ai)
#pragma unroll
            for (int m = 0; m < 4; ++m) { bf16_t* rowp = base + (size_t)(row0 + ai * HALF + m * 16) * ldc + col0;
#pragma unroll
                for (int bj = 0; bj < 2; ++bj) { f32x4 v0 = acc[ai][bj][m][0] + bv[bj][0], v1 = acc[ai][bj][m][1] + bv[bj][1];
                    if (ACT == 1) { f32x2 a = gelu_pk((f32x2){v0[0], v0[1]}), b = gelu_pk((f32x2){v0[2], v0[3]}), c = gelu_pk((f32x2){v1[0], v1[1]}), d = gelu_pk((f32x2){v1[2], v1[3]});
                        v0 = (f32x4){a.x, a.y, b.x, b.y}; v1 = (f32x4){c.x, c.y, d.x, d.y}; }
                    v0 = v0 * sc; v1 = v1 * sc; u32x4 w; w.x = cvt_pk_bf16(v0[0], v0[1]); w.y = cvt_pk_bf16(v0[2], v0[3]); w.z = cvt_pk_bf16(v1[0], v1[1]); w.w = cvt_pk_bf16(v1[2], v1[3]);
                    *(u32x4*)(rowp + bj * HALF) = w; } }
    }
};typedef unsigned u32x2 __attribute__((ext_vector_type(2)));
struct EpiResidA {
    static constexpr bool PERM = false, AFTER_DRAIN = false;
    bf16_t* hg; const float* g_old; const float* rms_old; const float* g; float* rowss; int ldc;
    __device__ __forceinline__ void operator()(const f32x4 (&acc)[2][2][4][2], const Unit& u, int wr, int wc, int fr, int fq) const {
        const int col0 = u.pn * BM + wc * 32 + 4 * fq;
        f32x4 gi[2][2], gg[2][2];
#pragma unroll
        for (int bj = 0; bj < 2; ++bj)
#pragma unroll
            for (int n = 0; n < 2; ++n) { const f32x4 go = *(const f32x4*)(g_old + col0 + bj * HALF + n * 16); gg[bj][n] = *(const f32x4*)(g + col0 + bj * HALF + n * 16);
                gi[bj][n] = (f32x4){__builtin_amdgcn_rcpf(go[0]), __builtin_amdgcn_rcpf(go[1]), __builtin_amdgcn_rcpf(go[2]), __builtin_amdgcn_rcpf(go[3])}; }
#pragma unroll
        for (int ai = 0; ai < 2; ++ai) {
            u32x2 hw[4][2][2]; float rm[4];
#pragma unroll
            for (int m = 0; m < 4; ++m) { const int row = u.pm * BM + ai * HALF + wr * 64 + m * 16 + fr; const size_t off = (size_t)row * ldc + col0;
                rm[m] = rms_old[row];
#pragma unroll
                for (int bj = 0; bj < 2; ++bj)
#pragma unroll
                    for (int n = 0; n < 2; ++n) hw[m][bj][n] = *(const u32x2*)(hg + off + bj * HALF + n * 16); }
            asm volatile("" ::: "memory");
#pragma unroll
            for (int m = 0; m < 4; ++m) {
                const int row = u.pm * BM + ai * HALF + wr * 64 + m * 16 + fr;
                const size_t off = (size_t)row * ldc + col0;
                float ss = 0.f;
#pragma unroll
                for (int bj = 0; bj < 2; ++bj)
#pragma unroll
                    for (int n = 0; n < 2; ++n) {
                        const int co = bj * HALF + n * 16;
                        const u32x2 h = hw[m][bj][n];
                        const f32x4 xr = (f32x4){__uint_as_float(h.x << 16), __uint_as_float(h.x & 0xffff0000u), __uint_as_float(h.y << 16), __uint_as_float(h.y & 0xffff0000u)};
                        const f32x4 v = xr * gi[bj][n] * rm[m] + acc[ai][bj][m][n];
                        ss += (v[0] * v[0] + v[1] * v[1]) + (v[2] * v[2] + v[3] * v[3]);
                        u32x2 w; w.x = cvt_pk_bf16(v[0] * gg[bj][n][0], v[1] * gg[bj][n][1]); w.y = cvt_pk_bf16(v[2] * gg[bj][n][2], v[3] * gg[bj][n][3]);
                        *(u32x2*)(hg + off + co) = w;
                    }
                ss += __shfl_xor(ss, 16); ss += __shfl_xor(ss, 32);
                if (fq == 0) atomicAdd(rowss + row, ss);
            }
            asm volatile("" ::: "memory");
        }
    }
};
struct EpiResidB {
    static constexpr bool PERM = false, AFTER_DRAIN = false;
    bf16_t* hg; const float* g; float* rowss; int ldc;
    __device__ __forceinline__ void operator()(const f32x4 (&acc)[2][2][4][2], const Unit& u, int wr, int wc, int fr, int fq) const {
        const int col0 = u.pn * BM + wc * 32 + 4 * fq;
        u32x2 hw[2][4][2][2];
#pragma unroll
        for (int ai = 0; ai < 2; ++ai)
#pragma unroll
            for (int m = 0; m < 4; ++m) { const size_t off = (size_t)(u.pm * BM + ai * HALF + wr * 64 + m * 16 + fr) * ldc + col0;
#pragma unroll
                for (int bj = 0; bj < 2; ++bj)
#pragma unroll
                    for (int n = 0; n < 2; ++n) hw[ai][m][bj][n] = *(const u32x2*)(hg + off + bj * HALF + n * 16); }
        f32x4 gi[2][2];
#pragma unroll
        for (int bj = 0; bj < 2; ++bj)
#pragma unroll
            for (int n = 0; n < 2; ++n) { const f32x4 gg = *(const f32x4*)(g + col0 + bj * HALF + n * 16);
                gi[bj][n] = (f32x4){__builtin_amdgcn_rcpf(gg[0]), __builtin_amdgcn_rcpf(gg[1]), __builtin_amdgcn_rcpf(gg[2]), __builtin_amdgcn_rcpf(gg[3])}; }
        asm volatile("" ::: "memory");
#pragma unroll
        for (int ai = 0; ai < 2; ++ai)
#pragma unroll
            for (int m = 0; m < 4; ++m) {
                const int row = u.pm * BM + ai * HALF + wr * 64 + m * 16 + fr;
                const size_t off = (size_t)row * ldc + col0;
                float ss = 0.f;
#pragma unroll
                for (int bj = 0; bj < 2; ++bj)
#pragma unroll
                    for (int n = 0; n < 2; ++n) {
                        const int co = bj * HALF + n * 16;
                        const u32x2 h = hw[ai][m][bj][n];
                        const f32x4 h1 = (f32x4){__uint_as_float(h.x << 16), __uint_as_float(h.x & 0xffff0000u), __uint_as_float(h.y << 16), __uint_as_float(h.y & 0xffff0000u)};
                        const f32x4 v = h1 * gi[bj][n] + acc[ai][bj][m][n];
                        ss += (v[0] * v[0] + v[1] * v[1]) + (v[2] * v[2] + v[3] * v[3]);
                        u32x2 w; w.x = cvt_pk_bf16(v[0], v[1]); w.y = cvt_pk_bf16(v[2], v[3]);
                        *(u32x2*)(hg + off + co) = w;
                    }
                ss += __shfl_xor(ss, 16); ss += __shfl_xor(ss, 32);
                if (fq == 0) atomicAdd(rowss + row, ss);
            }
    }
};
struct EpiBf16RS {
    static constexpr bool PERM = true, AFTER_DRAIN = false;
    bf16_t* O; int ldc; const float* rowss; float inv_n, eps;
    __device__ __forceinline__ void operator()(const f32x4 (&acc)[2][2][4][2], const Unit& u, int wr, int wc, int fr, int fq) const {
        const int row0 = u.pm * BM + wr * 64 + fr;
        float scv[2][4];
#pragma unroll
        for (int ai = 0; ai < 2; ++ai)
#pragma unroll
            for (int m = 0; m < 4; ++m) scv[ai][m] = rowss ? rowss[row0 + ai * HALF + m * 16] : 0.f;
        asm volatile("" ::: "memory");
#pragma unroll
        for (int ai = 0; ai < 2; ++ai)
#pragma unroll
            for (int m = 0; m < 4; ++m) { const int row = row0 + ai * HALF + m * 16;
                bf16_t* rowp = O + ((size_t)((u.pn * 2) * 16 + (row >> 11)) * 2048 + (row & 2047)) * 128 + wc * 32 + 8 * fq;
                const float sc = rowss ? __builtin_amdgcn_rsqf(scv[ai][m] * inv_n + eps) : 1.f;
#pragma unroll
                for (int bj = 0; bj < 2; ++bj) { const f32x4 v0 = acc[ai][bj][m][0] * sc, v1 = acc[ai][bj][m][1] * sc;
                    u32x4 w; w.x = cvt_pk_bf16(v0[0], v0[1]); w.y = cvt_pk_bf16(v0[2], v0[3]); w.z = cvt_pk_bf16(v1[0], v1[1]); w.w = cvt_pk_bf16(v1[2], v1[3]);
                    *(u32x4*)(rowp + (size_t)bj * (16 * 2048 * 128)) = w; } }
    }
};
template <class Epi, class Sched, bool ALIGN_EPI = false, bool SP2 = false>
__device__ __forceinline__ void gemm_phase(PG8_LAS unsigned char* lds, const Gemm g, const Sched& S, const Epi& E) {
    const int tid = threadIdx.x, wid = __builtin_amdgcn_readfirstlane(tid >> 6), lane = tid & 63, wr = wid >> 2, wc = wid & 3, fr = lane & 15, fq = lane >> 4;
    const int K = g.K, nt = K / BK;
    unsigned voffA[2], voffB[2];
#pragma unroll
    for (int i = 0; i < 2; ++i) { int R, C; stage_rc(tid * 16 + i * 8192, R, C); const int Rb = Epi::PERM ? ((R & ~31) + perm32(R & 31)) : R;
        voffA[i] = (unsigned)(R * K + C) * 2u; voffB[i] = (unsigned)(Rb * K + C) * 2u; }
    const size_t kstep = (size_t)(BK * 2);
    const size_t hstep = (size_t)HALF * K * 2;
    const size_t tstep = 2 * hstep;
    const unsigned ldsw = (unsigned)wid * 1024u;
    const int aoff = lds_byte(wr * 64 + fr, fq * 8), boff = lds_byte(wc * 32 + fr, fq * 8);
#define PG8_SA(b, h) (((b) * 2 + (h)) * HTB)
#define PG8_SB(b, h) ((4 + (b) * 2 + (h)) * HTB)
#define PG8_STAGE(bufoff, gbase, voff) do { _Pragma("unroll") for (int _i = 0; _i < 2; ++_i) \
        __builtin_amdgcn_global_load_lds((const unsigned*)((const char*)(gbase) + (voff)[_i]), (PG8_LAS unsigned*)(lds + (bufoff) + ldsw + _i * 8192), 16, 0, 0); } while (0)
#define PG8_LDA(dst, b, h) do { _Pragma("unroll") for (int m = 0; m < 4; ++m) _Pragma("unroll") for (int k = 0; k < 2; ++k) dst[m][k] = *(const PG8_LAS bf16x8*)(lds + PG8_SA(b, h) + aoff + m * 2048 + k * 1024); } while (0)
#define PG8_LDB(dst, b, h) do { _Pragma("unroll") for (int n = 0; n < 2; ++n) _Pragma("unroll") for (int k = 0; k < 2; ++k) dst[n][k] = *(const PG8_LAS bf16x8*)(lds + PG8_SB(b, h) + boff + n * 2048 + k * 1024); } while (0)
#define PG8_MMA(ai, bj, At, Bt) do { __builtin_amdgcn_s_setprio(1); _Pragma("unroll") for (int m = 0; m < 4; ++m) _Pragma("unroll") for (int n = 0; n < 2; ++n) _Pragma("unroll") for (int k = 0; k < 2; ++k) \
        acc[ai][bj][m][n] = __builtin_amdgcn_mfma_f32_16x16x32_bf16(Bt[n][k], At[m][k], acc[ai][bj][m][n], 0, 0, 0); __builtin_amdgcn_s_setprio(0); } while (0)
#define PG8_WAIT_V(n) asm volatile("s_waitcnt vmcnt(" #n ")" ::: "memory")
#define PG8_WAIT_L(n) asm volatile("s_waitcnt lgkmcnt(" #n ")" ::: "memory")
#define PG8_BAR __builtin_amdgcn_s_barrier()
#define PG8_SCHED __builtin_amdgcn_sched_barrier(0)
    Unit cur, nxt; int ui = 0;
    if (!S.next(0, cur)) return;
    f32x4 acc[2][2][4][2];
#pragma unroll
    for (int a = 0; a < 2; ++a)
#pragma unroll
        for (int b = 0; b < 2; ++b)
#pragma unroll
            for (int m = 0; m < 4; ++m)
#pragma unroll
                for (int n = 0; n < 2; ++n) acc[a][b][m][n] = (f32x4){0.f, 0.f, 0.f, 0.f};
    bf16x8 At[4][2], B0[2][2], B1[2][2];
    const char* cA = (const char*)g.A + (size_t)cur.pm * tstep; const char* cB = (const char*)g.Bt + (size_t)cur.pn * tstep;
    S.a_ready(cur);
    if constexpr (SP2) {
        PG8_STAGE(PG8_SB(0, 0), cB, voffB); PG8_STAGE(PG8_SB(0, 1), cB + hstep, voffB); PG8_STAGE(PG8_SA(0, 0), cA, voffA); PG8_STAGE(PG8_SA(0, 1), cA + hstep, voffA);
        if (wr == 1) PG8_BAR;
        PG8_WAIT_V(2); PG8_BAR;
        PG8_STAGE(PG8_SB(1, 0), cB + kstep, voffB); PG8_STAGE(PG8_SA(1, 0), cA + kstep, voffA); PG8_STAGE(PG8_SB(1, 1), cB + hstep + kstep, voffB);
        PG8_WAIT_V(6); PG8_BAR;
    } else {
        PG8_STAGE(PG8_SB(0, 0), cB, voffB); PG8_STAGE(PG8_SA(0, 0), cA, voffA); PG8_STAGE(PG8_SB(0, 1), cB + hstep, voffB); PG8_STAGE(PG8_SA(0, 1), cA + hstep, voffA);
        if (wr == 1) PG8_BAR;
        PG8_WAIT_V(4); PG8_BAR;
        PG8_STAGE(PG8_SB(1, 0), cB + kstep, voffB); PG8_STAGE(PG8_SA(1, 0), cA + kstep, voffA); PG8_STAGE(PG8_SB(1, 1), cB + hstep + kstep, voffB);
        PG8_WAIT_V(6); PG8_BAR;
    }
    for (;;) {
        const bool has_next = S.next(ui + 1, nxt);
        const char* nA = has_next ? (const char*)g.A + (size_t)nxt.pm * tstep : cA; const char* nB = has_next ? (const char*)g.Bt + (size_t)nxt.pn * tstep : cB;
        for (int t = 0; t < nt; t += 2) {
            const bool last = (t == nt - 2);
            const char* a1 = cA + (size_t)(t + 1) * kstep;
            const char* a2 = last ? nA : cA + (size_t)(t + 2) * kstep; const char* b2 = last ? nB : cB + (size_t)(t + 2) * kstep;
            const char* a3 = a2 + kstep; const char* b3 = b2 + kstep;
            if (last && has_next) S.a_ready(nxt);
            if constexpr (SP2) {
            PG8_LDB(B0, 0, 0); PG8_LDB(B1, 0, 1); PG8_SCHED; PG8_LDA(At, 0, 0); PG8_STAGE(PG8_SA(1, 1), a1 + hstep, voffA);
            PG8_WAIT_V(8); PG8_WAIT_L(0); PG8_BAR; PG8_MMA(0, 0, At, B0); PG8_MMA(0, 1, At, B1); PG8_BAR; PG8_SCHED;
            PG8_LDA(At, 0, 1); PG8_STAGE(PG8_SB(0, 0), b2, voffB); PG8_STAGE(PG8_SB(0, 1), b2 + hstep, voffB); PG8_STAGE(PG8_SA(0, 0), a2, voffA);
            PG8_WAIT_V(8); PG8_WAIT_L(0); PG8_BAR; PG8_MMA(1, 0, At, B0); PG8_MMA(1, 1, At, B1); PG8_BAR; PG8_SCHED;
            PG8_LDB(B0, 1, 0); PG8_LDB(B1, 1, 1); PG8_SCHED; PG8_LDA(At, 1, 0); PG8_STAGE(PG8_SA(0, 1), a2 + hstep, voffA);
            PG8_WAIT_V(8); PG8_WAIT_L(0); PG8_BAR; PG8_MMA(0, 0, At, B0); PG8_MMA(0, 1, At, B1); PG8_BAR; PG8_SCHED;
            PG8_LDA(At, 1, 1); PG8_STAGE(PG8_SB(1, 0), b3, voffB); PG8_STAGE(PG8_SB(1, 1), b3 + hstep, voffB); PG8_STAGE(PG8_SA(1, 0), a3, voffA);
            PG8_WAIT_V(8); PG8_WAIT_L(0); PG8_BAR; PG8_MMA(1, 0, At, B0); PG8_MMA(1, 1, At, B1); PG8_BAR; PG8_SCHED;
            } else {
            PG8_LDB(B0, 0, 0); PG8_SCHED; PG8_LDA(At, 0, 0); PG8_STAGE(PG8_SA(1, 1), a1 + hstep, voffA);
            PG8_WAIT_L(8); PG8_BAR; PG8_WAIT_L(0); PG8_MMA(0, 0, At, B0); PG8_BAR; PG8_SCHED;
            PG8_LDB(B1, 0, 1); PG8_STAGE(PG8_SB(0, 0), b2, voffB);
            PG8_BAR; PG8_WAIT_L(0); PG8_MMA(0, 1, At, B1); PG8_BAR;
            PG8_LDA(At, 0, 1); PG8_STAGE(PG8_SA(0, 0), a2, voffA);
            PG8_BAR; PG8_WAIT_L(0); PG8_MMA(1, 0, At, B0); PG8_BAR; PG8_SCHED;
            PG8_STAGE(PG8_SB(0, 1), b2 + hstep, voffB);
            PG8_WAIT_V(6); PG8_BAR; PG8_MMA(1, 1, At, B1); PG8_BAR;
            PG8_LDB(B0, 1, 0); PG8_SCHED; PG8_LDA(At, 1, 0); PG8_STAGE(PG8_SA(0, 1), a2 + hstep, voffA);
            PG8_WAIT_L(8); PG8_BAR; PG8_WAIT_L(0); PG8_MMA(0, 0, At, B0); PG8_BAR; PG8_SCHED;
            PG8_LDB(B1, 1, 1); PG8_STAGE(PG8_SB(1, 0), b3, voffB);
            PG8_BAR; PG8_WAIT_L(0); PG8_MMA(0, 1, At, B1); PG8_BAR;
            PG8_LDA(At, 1, 1); PG8_STAGE(PG8_SA(1, 0), a3, voffA);
            PG8_BAR; PG8_WAIT_L(0); PG8_MMA(1, 0, At, B0); PG8_BAR; PG8_SCHED;
            PG8_STAGE(PG8_SB(1, 1), b3 + hstep, voffB);
            PG8_WAIT_V(6); PG8_BAR; PG8_MMA(1, 1, At, B1); PG8_BAR;
            }
        }
        if constexpr (ALIGN_EPI) { if (wr == 0) PG8_BAR; }
        if constexpr (!Epi::AFTER_DRAIN) { E(acc, cur, wr, wc, fr, fq); S.done(cur); }
        if (!has_next) break;
#pragma unroll
        for (int a = 0; a < 2; ++a)
#pragma unroll
            for (int b = 0; b < 2; ++b)
#pragma unroll
                for (int m = 0; m < 4; ++m)
#pragma unroll
                    for (int n = 0; n < 2; ++n) acc[a][b][m][n] = (f32x4){0.f, 0.f, 0.f, 0.f};
        cur = nxt; cA = nA; cB = nB; ++ui;
        if constexpr (ALIGN_EPI) { if (wr == 1) PG8_BAR; }
    }
    PG8_WAIT_V(0);
    if constexpr (!ALIGN_EPI) { if (wr == 0) PG8_BAR; }
    PG8_BAR;
    if constexpr (Epi::AFTER_DRAIN) { E.fused(acc, cur, wr, wc, fr, fq, lds, wid, lane); S.done(cur); }
#undef PG8_SA
#undef PG8_SB
#undef PG8_STAGE
#undef PG8_LDA
#undef PG8_LDB
#undef PG8_MMA
#undef PG8_WAIT_V
#undef PG8_WAIT_L
#undef PG8_BAR
#undef PG8_SCHED
}
}
namespace att {
typedef unsigned short bf16_t;
using bf16x8 = __attribute__((ext_vector_type(8))) short;
using s16x4  = __attribute__((ext_vector_type(4))) short;
using f32x16 = __attribute__((ext_vector_type(16))) float;
using u32x4  = __attribute__((ext_vector_type(4))) unsigned;
using f32x4v = __attribute__((ext_vector_type(4))) float;
constexpr int NW = 8, QBLK = 32, KVBLK = 64;
constexpr int SHM_V = KVBLK * 128 * 2, SHM_K = KVBLK * 128 * 2;
constexpr int ATT_WS_OFF = 2 * SHM_V + 2 * SHM_K;
constexpr int ATT_STG_OFF = ATT_WS_OFF + NW * 64 * 4;
constexpr int STG_PITCH = 136, STG_BYTES = 32 * STG_PITCH * 2;
constexpr int ATT_LDS_BYTES = ATT_STG_OFF + NW * STG_BYTES;
constexpr float LOG2E = 1.4426950408889634f;
constexpr float THR = 8.f;
#define KSWZ(row, colB) ((row) * 256 + ((colB) ^ (((row) & 7) << 4)))
#define SBAR() __builtin_amdgcn_sched_barrier(0)
__device__ __forceinline__ int crow(int r, int hi) { return (r & 3) + 8 * (r >> 2) + 4 * hi; }
__device__ __forceinline__ unsigned cvtpk(float lo, float hi) {
  unsigned r; asm volatile("v_cvt_pk_bf16_f32 %0, %1, %2" : "=v"(r) : "v"(lo), "v"(hi)); return r;
}
__device__ __forceinline__ float bf2f(unsigned short v) { return __uint_as_float(((unsigned)v) << 16); }
__device__ __forceinline__ float bfs(short v) { return __uint_as_float(((unsigned)(unsigned short)v) << 16); }
__device__ __forceinline__ u32x4 pack8(const float* v) { u32x4 w; w.x = cvtpk(v[0], v[1]); w.y = cvtpk(v[2], v[3]); w.z = cvtpk(v[4], v[5]); w.w = cvtpk(v[6], v[7]); return w; }
__device__ __forceinline__ float swapmax(float v) { auto rr = __builtin_amdgcn_permlane32_swap(__float_as_uint(v), __float_as_uint(v), false, false); return fmaxf(__uint_as_float(rr[0]), __uint_as_float(rr[1])); }
__device__ __forceinline__ float swapsum(float v) { auto rr = __builtin_amdgcn_permlane32_swap(__float_as_uint(v), __float_as_uint(v), false, false); return __uint_as_float(rr[0]) + __uint_as_float(rr[1]); }

template <bool ALIBI>
__device__ __forceinline__ void partialSM(f32x16& p0, f32x16& p1, float& m_reg, float& mn, float& alpha, const float C, const float thr, const float nsl2, const float fb) {
  if constexpr (ALIBI) {
    float fbv = fb; asm volatile("" : "+v"(fbv));
#pragma unroll
    for (int r = 0; r < 16; ++r) { const float cr = (float)((r & 3) + 8 * (r >> 2));
      p0[r] = fmaf(fabsf(fbv - cr), nsl2, p0[r] * C); p1[r] = fmaf(fabsf(fbv - (cr + 32.f)), nsl2, p1[r] * C); }
    float pmax = p0[0];
#pragma unroll
    for (int r = 1; r < 16; ++r) pmax = fmaxf(pmax, p0[r]);
#pragma unroll
    for (int r = 0; r < 16; ++r) pmax = fmaxf(pmax, p1[r]);
    pmax = swapmax(pmax);
    if (__builtin_expect(__all(pmax - m_reg <= thr), 1)) { mn = m_reg; alpha = 1.f; }
    else { mn = fmaxf(m_reg, pmax); alpha = __builtin_amdgcn_exp2f(m_reg - mn); m_reg = mn; }
#pragma unroll
    for (int r = 0; r < 16; ++r) { p0[r] = p0[r] - mn; p1[r] = p1[r] - mn; }
#pragma unroll
    for (int r = 0; r < 16; ++r) p0[r] = __builtin_amdgcn_exp2f(p0[r]);
  } else {
    float pmax = p0[0];
#pragma unroll
    for (int r = 1; r < 16; ++r) pmax = fmaxf(pmax, p0[r]);
#pragma unroll
    for (int r = 0; r < 16; ++r) pmax = fmaxf(pmax, p1[r]);
    pmax = swapmax(pmax);
    if (__builtin_expect(__all(pmax - m_reg <= thr), 1)) { mn = m_reg; alpha = 1.f; }
    else { mn = fmaxf(m_reg, pmax); alpha = __builtin_amdgcn_exp2f((m_reg - mn) * C); m_reg = mn; }
    const float mnC = -mn * C;
#pragma unroll
    for (int r = 0; r < 16; ++r) { p0[r] = fmaf(p0[r], C, mnC); p1[r] = fmaf(p1[r], C, mnC); }
#pragma unroll
    for (int r = 0; r < 16; ++r) p0[r] = __builtin_amdgcn_exp2f(p0[r]);
  }
}
#define PK4(P, BASE, OUT) do { unsigned a0 = cvtpk(P[BASE + 0], P[BASE + 1]), a1 = cvtpk(P[BASE + 2], P[BASE + 3]);   \
    unsigned b0 = cvtpk(P[BASE + 4], P[BASE + 5]), b1 = cvtpk(P[BASE + 6], P[BASE + 7]);                              \
    auto r0 = __builtin_amdgcn_permlane32_swap(a0, b0, false, false); auto r1 = __builtin_amdgcn_permlane32_swap(a1, b1, false, false); \
    u32x4 w = {r0[0], r1[0], r0[1], r1[1]}; OUT = *reinterpret_cast<bf16x8*>(&w); } while (0)
__device__ __forceinline__ void finishSM(f32x16& p0, f32x16& p1, float alpha, float& l_reg, bf16x8& pa0, bf16x8& pa1, bf16x8& pa2, bf16x8& pa3) {
#pragma unroll
  for (int r = 0; r < 16; ++r) p1[r] = __builtin_amdgcn_exp2f(p1[r]);
  float ps = 0;
#pragma unroll
  for (int r = 0; r < 16; ++r) ps += p0[r];
#pragma unroll
  for (int r = 0; r < 16; ++r) ps += p1[r];
  ps = swapsum(ps);
  l_reg = l_reg * alpha + ps;
  PK4(p0, 0, pa0); PK4(p0, 8, pa1); PK4(p1, 0, pa2); PK4(p1, 8, pa3);
}
template <bool ALIBI>
__device__ __forceinline__ void score_init(f32x16& p0, f32x16& p1, const float fb, const float kb, const int rel) {
  if constexpr (!ALIBI) { p0 = f32x16{}; p1 = f32x16{}; }
  else {
    float fbv = fb; asm volatile("" : "+v"(fbv));
    if (rel >= 63) {
      const float A = kb * fbv, B = -kb;
#pragma unroll
      for (int r = 0; r < 16; ++r) { const float cr = (float)((r & 3) + 8 * (r >> 2)); p0[r] = fmaf(cr, B, A); p1[r] = fmaf(cr + 32.f, B, A); }
    } else if (rel <= -31) {
      const float A = -kb * fbv, B = kb;
#pragma unroll
      for (int r = 0; r < 16; ++r) { const float cr = (float)((r & 3) + 8 * (r >> 2)); p0[r] = fmaf(cr, B, A); p1[r] = fmaf(cr + 32.f, B, A); }
    } else {
#pragma unroll
      for (int r = 0; r < 16; ++r) { const float cr = (float)((r & 3) + 8 * (r >> 2)); p0[r] = kb * fabsf(fbv - cr); p1[r] = kb * fabsf(fbv - (cr + 32.f)); }
    }
  }
}
template <int ND>
__device__ __forceinline__ void qkt(f32x16& p0, f32x16& p1, const bf16_t* Ks, const bf16x8* qr, int r32, int hi, int dlo) {
#pragma unroll
  for (int d0 = 0; d0 < ND; ++d0) { int cb = ((dlo + d0) * 16 + hi * 8) * 2;
    bf16x8 b0 = *reinterpret_cast<const bf16x8*>((const char*)Ks + KSWZ(r32, cb));
    bf16x8 b1 = *reinterpret_cast<const bf16x8*>((const char*)Ks + KSWZ(32 + r32, cb));
    p0 = __builtin_amdgcn_mfma_f32_32x32x16_bf16(b0, qr[d0], p0, 0, 0, 0);
    p1 = __builtin_amdgcn_mfma_f32_32x32x16_bf16(b1, qr[d0], p1, 0, 0, 0); }
}
__device__ __forceinline__ int v_st(int k, int c) { const int kk = (k & ~0xC) | ((k & 4) << 1) | ((k & 8) >> 1); return ((kk >> 3) * 4 + (c >> 5)) * 512 + ((kk & 7) * 32 + (c & 31)) * 2; }
__device__ __forceinline__ int v_rd_base(int lane) { return ((lane & 3) << 3) | (((lane >> 2) & 3) << 6) | (((lane >> 4) & 1) << 5) | (((lane >> 5) & 1) << 8); }
constexpr int v_rd_off(int d0, int ks, int half) { return d0 * 512 + ks * 4096 + half * 2048; }
template <int OFF> __device__ __forceinline__ s16x4 tr_read(int vb) {
  s16x4 r; asm volatile("ds_read_b64_tr_b16 %0, %1 offset:%2" : "=&v"(r) : "v"(vb), "i"(OFF) : "memory"); return r;
}
#define PKV(L, H) (bf16x8){L[0], L[1], L[2], L[3], H[0], H[1], H[2], H[3]}
template <int D0> __device__ __forceinline__ void pv_one(f32x16& od, int vb, bf16x8 pa0, bf16x8 pa1, bf16x8 pa2, bf16x8 pa3) {
  const s16x4 l0 = tr_read<v_rd_off(D0, 0, 0)>(vb), h0 = tr_read<v_rd_off(D0, 0, 1)>(vb), l1 = tr_read<v_rd_off(D0, 1, 0)>(vb), h1 = tr_read<v_rd_off(D0, 1, 1)>(vb);
  const s16x4 l2 = tr_read<v_rd_off(D0, 2, 0)>(vb), h2 = tr_read<v_rd_off(D0, 2, 1)>(vb), l3 = tr_read<v_rd_off(D0, 3, 0)>(vb), h3 = tr_read<v_rd_off(D0, 3, 1)>(vb);
  asm volatile("s_waitcnt lgkmcnt(0)" ::: "memory"); SBAR();
  od = __builtin_amdgcn_mfma_f32_32x32x16_bf16(pa0, PKV(l0, h0), od, 0, 0, 0);
  od = __builtin_amdgcn_mfma_f32_32x32x16_bf16(pa1, PKV(l1, h1), od, 0, 0, 0);
  od = __builtin_amdgcn_mfma_f32_32x32x16_bf16(pa2, PKV(l2, h2), od, 0, 0, 0);
  od = __builtin_amdgcn_mfma_f32_32x32x16_bf16(pa3, PKV(l3, h3), od, 0, 0, 0);
}
__device__ __forceinline__ void pv_d0(f32x16* o, int vb, bf16x8 pa0, bf16x8 pa1, bf16x8 pa2, bf16x8 pa3) {
  pv_one<0>(o[0], vb, pa0, pa1, pa2, pa3); pv_one<1>(o[1], vb, pa0, pa1, pa2, pa3); pv_one<2>(o[2], vb, pa0, pa1, pa2, pa3); pv_one<3>(o[3], vb, pa0, pa1, pa2, pa3);
}
template <int D0> __device__ __forceinline__ void pv_one32(f32x16& od, int vb, bf16x8 pa0, bf16x8 pa1) {
  const s16x4 l0 = tr_read<v_rd_off(D0, 0, 0)>(vb), h0 = tr_read<v_rd_off(D0, 0, 1)>(vb), l1 = tr_read<v_rd_off(D0, 1, 0)>(vb), h1 = tr_read<v_rd_off(D0, 1, 1)>(vb);
  asm volatile("s_waitcnt lgkmcnt(0)" ::: "memory"); SBAR();
  od = __builtin_amdgcn_mfma_f32_32x32x16_bf16(pa0, PKV(l0, h0), od, 0, 0, 0);
  od = __builtin_amdgcn_mfma_f32_32x32x16_bf16(pa1, PKV(l1, h1), od, 0, 0, 0);
}

template <int ND, bool ALIBI, int DLO, bool QROPE = false>
__device__ __forceinline__ void attn_core(const bf16_t* __restrict__ Qb, const bf16_t* __restrict__ Kh, const int voff, const int ldq, const int ldk,
                                          const float scale, const float nsl2, const int qpos0, const int seq, char* lds, f32x16 (&o)[4], const float* tab = nullptr  ) {
  int tid = threadIdx.x; asm volatile("" : "+v"(tid));
  constexpr int dlo = DLO;
  const int wid = tid >> 6, lane = tid & 63, r32 = lane & 31, hi = lane >> 5;
  bf16_t* V_lds = (bf16_t*)lds; bf16_t* K_lds = (bf16_t*)(lds + 2 * SHM_V);
  float* ws = (float*)(lds + ATT_WS_OFF) + wid * 64; float* li_l = ws; float* al_l = ws + 32;
  const float C = scale * LOG2E; const float thr = THR / scale; const float kb = nsl2 / C;
  const int qw = __builtin_amdgcn_readfirstlane(qpos0 + wid * QBLK);
  const float fq0 = (float)(qpos0 + wid * QBLK + r32 - 4 * hi);
  float m_reg = -1e30f, l_reg = 0; bf16x8 qr[ND];
#pragma unroll
  for (int d = 0; d < 4; ++d) o[d] = f32x16{};
  const bf16_t* Qw = Qb + (unsigned)((wid * QBLK + r32) * ldq + hi * 8 + dlo * 16);
#pragma unroll
  for (int d0 = 0; d0 < ND; ++d0) qr[d0] = *reinterpret_cast<const bf16x8*>(Qw + d0 * 16);
  if constexpr (QROPE) {
    const float* ropec = tab; const float* ropes = tab + 2048; const float* gq = tab + 4096;
    float xf[8][8]; float ss = 0.f;
#pragma unroll
    for (int d0 = 0; d0 < 8; ++d0)
#pragma unroll
      for (int e = 0; e < 8; ++e) { xf[d0][e] = bfs(qr[d0][e]); ss += xf[d0][e] * xf[d0][e]; }
    ss = swapsum(ss);
    const float rinv = 1.f / sqrtf(ss * (1.f / 128.f) + 1e-6f);
#pragma unroll
    for (int d0 = 0; d0 < 8; ++d0) { const f32x4v g0 = *reinterpret_cast<const f32x4v*>(gq + 16 * d0 + 8 * hi), g1 = *reinterpret_cast<const f32x4v*>(gq + 16 * d0 + 8 * hi + 4);
#pragma unroll
      for (int e = 0; e < 4; ++e) { xf[d0][e] = xf[d0][e] * rinv * g0[e]; xf[d0][4 + e] = xf[d0][4 + e] * rinv * g1[e]; } }
    const int spos = qpos0 + wid * QBLK + r32;
#pragma unroll
    for (int sec = 0; sec < 2; ++sec) { const int id = sec ? (spos & 63) : (spos >> 6);
#pragma unroll
      for (int hf = 0; hf < 2; ++hf) { const int j0 = id * 32 + 16 * hf + 8 * hi; const int da = 4 * sec + hf, db = da + 2;
        const f32x4v c0 = *reinterpret_cast<const f32x4v*>(ropec + j0), c1 = *reinterpret_cast<const f32x4v*>(ropec + j0 + 4);
        const f32x4v s0 = *reinterpret_cast<const f32x4v*>(ropes + j0), s1 = *reinterpret_cast<const f32x4v*>(ropes + j0 + 4);
#pragma unroll
        for (int e = 0; e < 8; ++e) { const float c = (e < 4) ? c0[e & 3] : c1[e & 3], sn = (e < 4) ? s0[e & 3] : s1[e & 3];
          const float x1 = xf[da][e], x2 = xf[db][e]; xf[da][e] = x1 * c - x2 * sn; xf[db][e] = x2 * c + x1 * sn; } } }
#pragma unroll
    for (int d0 = 0; d0 < 8; ++d0) { u32x4 w = pack8(xf[d0]); qr[d0] = *reinterpret_cast<bf16x8*>(&w); }
  }
  const int sr = tid >> 4, sc = (tid & 15) * 8, vst0 = v_st(sr, sc); constexpr int vst1d = 8192;
  const int vb0 = (int)(uintptr_t)V_lds + v_rd_base(lane);
  struct { bf16x8 vs0, vs1, ks0, ks1; } sr_[2];
  const unsigned lo0 = (unsigned)(sr * ldk + sc), lo1 = lo0 + (unsigned)(32 * ldk);
#define SLOAD(i, k0) do { const bf16_t* Kt_ = Kh + (long)(k0) * ldk; const bf16_t* Vt_ = Kt_ + voff; \
    sr_[i].vs0 = *reinterpret_cast<const bf16x8*>(Vt_ + lo0); sr_[i].vs1 = *reinterpret_cast<const bf16x8*>(Vt_ + lo1); \
    sr_[i].ks0 = *reinterpret_cast<const bf16x8*>(Kt_ + lo0); sr_[i].ks1 = *reinterpret_cast<const bf16x8*>(Kt_ + lo1); } while (0)
#define SWRITE(b, i) do { *(bf16x8*)((char*)V_lds + (b) * SHM_V + vst0) = sr_[i].vs0;          \
    *(bf16x8*)((char*)V_lds + (b) * SHM_V + vst0 + vst1d) = sr_[i].vs1; int kc = sc * 2;               \
    *(bf16x8*)((char*)K_lds + (b) * SHM_K + KSWZ(sr, kc)) = sr_[i].ks0;                       \
    *(bf16x8*)((char*)K_lds + (b) * SHM_K + KSWZ(32 + sr, kc)) = sr_[i].ks1; } while (0)
#define SWAIT() asm volatile("s_waitcnt vmcnt(4)" ::: "memory")
#define RESC(a) do { if (__any((a) < 1.f)) { if (hi == 0) al_l[r32] = (a); asm volatile("s_waitcnt lgkmcnt(0)" ::: "memory"); \
    _Pragma("unroll") for (int d = 0; d < 4; ++d) _Pragma("unroll") for (int r = 0; r < 16; ++r) o[d][r] *= al_l[crow(r, hi)]; } } while (0)
  f32x16 pA0, pA1, pB0, pB1; float mnA, mnB, alA, alB; bf16x8 pa0, pa1, pa2, pa3; const int NT = seq / KVBLK;
  constexpr int SE = 0, SO = 1;
  SLOAD(SE, 0); asm volatile("s_waitcnt vmcnt(0)" ::: "memory"); SWRITE(0, SE); __syncthreads();
  score_init<ALIBI>(pA0, pA1, fq0, kb, qw); qkt<ND>(pA0, pA1, K_lds, qr, r32, hi, dlo); partialSM<false>(pA0, pA1, m_reg, mnA, alA, C, thr, 0.f, 0.f);
  SLOAD(SO, KVBLK); if (2 < NT) SLOAD(SE, 2 * KVBLK);
  SWAIT(); SWRITE(1, SO); __syncthreads();
  for (int j = 1; j + 1 < NT; j += 2) {
    SBAR(); score_init<ALIBI>(pB0, pB1, fq0 - (float)(j * KVBLK), kb, qw - j * KVBLK); qkt<ND>(pB0, pB1, (bf16_t*)((char*)K_lds + SHM_K), qr, r32, hi, dlo);
    finishSM(pA0, pA1, alA, l_reg, pa0, pa1, pa2, pa3); SBAR();
    SLOAD(SO, (j + 2) * KVBLK); SBAR();
    pv_d0(o, vb0, pa0, pa1, pa2, pa3); partialSM<false>(pB0, pB1, m_reg, mnB, alB, C, thr, 0.f, 0.f);
    __syncthreads(); SWAIT(); SWRITE(0, SE);
    RESC(alB); __syncthreads();
    SBAR(); score_init<ALIBI>(pA0, pA1, fq0 - (float)((j + 1) * KVBLK), kb, qw - (j + 1) * KVBLK); qkt<ND>(pA0, pA1, K_lds, qr, r32, hi, dlo);
    finishSM(pB0, pB1, alB, l_reg, pa0, pa1, pa2, pa3); SBAR();
    if (j + 3 < NT) SLOAD(SE, (j + 3) * KVBLK); SBAR();
    pv_d0(o, vb0 + (int)SHM_V, pa0, pa1, pa2, pa3); partialSM<false>(pA0, pA1, m_reg, mnA, alA, C, thr, 0.f, 0.f);
    __syncthreads(); SWAIT(); SWRITE(1, SO);
    RESC(alA); __syncthreads();
  }
  SBAR(); score_init<ALIBI>(pB0, pB1, fq0 - (float)((NT - 1) * KVBLK), kb, qw - (NT - 1) * KVBLK); qkt<ND>(pB0, pB1, (bf16_t*)((char*)K_lds + SHM_K), qr, r32, hi, dlo);
  finishSM(pA0, pA1, alA, l_reg, pa0, pa1, pa2, pa3); SBAR();
  pv_d0(o, vb0, pa0, pa1, pa2, pa3); partialSM<false>(pB0, pB1, m_reg, mnB, alB, C, thr, 0.f, 0.f);
  __syncthreads(); RESC(alB);
  finishSM(pB0, pB1, alB, l_reg, pa0, pa1, pa2, pa3); SBAR();
  pv_d0(o, vb0 + (int)SHM_V, pa0, pa1, pa2, pa3);
  if (hi == 0) li_l[r32] = l_reg; asm volatile("s_waitcnt lgkmcnt(0)" ::: "memory");
#pragma unroll
  for (int r = 0; r < 16; ++r) { const float rl = __builtin_amdgcn_rcpf(li_l[crow(r, hi)]);
#pragma unroll
    for (int d0 = 0; d0 < 4; ++d0) o[d0][r] *= rl; }
#undef SLOAD
#undef SWRITE
#undef SWAIT
#undef RESC
}
__device__ __forceinline__ void stage_o(const f32x16 (&o)[4], bf16_t* stg, int r32, int hi) {
  asm volatile("" ::: "memory");
#pragma unroll
  for (int r = 0; r < 16; ++r) { const int row = crow(r, hi);
#pragma unroll
    for (int d0 = 0; d0 < 4; d0 += 1) { const unsigned w = cvtpk(o[d0][r], 0.f); stg[row * STG_PITCH + d0 * 32 + r32] = (bf16_t)(w & 0xffffu); } }
  asm volatile("s_waitcnt lgkmcnt(0)" ::: "memory");
}
__device__ __forceinline__ bf16x8 stage_rd(const bf16_t* stg, int lane, int i) { return *reinterpret_cast<const bf16x8*>(stg + (lane >> 1) * STG_PITCH + (lane & 1) * 64 + i * 8); }
__device__ __forceinline__ float silu(float g) { return g * __builtin_amdgcn_rcpf(1.f + __builtin_amdgcn_exp2f(-g * LOG2E)); }

constexpr long HSTRIDE = 16L * 2048 * 128;
__device__ __forceinline__ const bf16_t* hm(const bf16_t* P, int ch, int b) { return P + ((long)(ch * 16 + b) * 2048) * 128; }
constexpr int SEQ = 2048;
__device__ __forceinline__ void unit_A(int b, int h, int qb, const bf16_t* P1, bf16_t* Y, char* lds, const float* tab) {
  const long tok0 = (long)b * SEQ + qb * 256; const int kvh = h >> 2;
  f32x16 o[4];
  attn_core<8, false, 0, true>(hm(P1, h, b) + (long)qb * 256 * 128, hm(P1, 8 + kvh, b), (int)(2 * HSTRIDE), 128, 128,
                      0.08838834764831845f, 0.f, qb * 256, SEQ, lds, o, tab);
  int tid = threadIdx.x; asm volatile("" : "+v"(tid));
  const int wid = tid >> 6, lane = tid & 63, r32 = lane & 31, hi = lane >> 5;
  bf16_t* stg = (bf16_t*)(lds + ATT_STG_OFF + wid * STG_BYTES);
  const long tok = tok0 + wid * 32 + (lane >> 1); const int ch = (lane & 1) * 64;
  const bf16_t* gp = hm(P1, 36 + h, b) + (long)(qb * 256 + wid * 32 + (lane >> 1)) * 128 + ch; bf16_t* yp = Y + tok * 2048 + h * 128 + ch;
  bf16x8 gv[8];
  asm volatile("" : "+v"(gp));
#pragma unroll
  for (int i = 0; i < 8; ++i) gv[i] = *reinterpret_cast<const bf16x8*>(gp + i * 8);
  stage_o(o, stg, r32, hi);
#pragma unroll
  for (int i = 0; i < 8; ++i) { const bf16x8 ov = stage_rd(stg, lane, i); float v[8];
#pragma unroll
    for (int e = 0; e < 8; ++e) v[e] = bfs(ov[e]) * silu(bfs(gv[i][e]));
    *reinterpret_cast<u32x4*>(yp + i * 8) = pack8(v); }
  asm volatile("s_waitcnt lgkmcnt(0)" ::: "memory");
}
__device__ __forceinline__ void unit_B(int b, int h, int qb, const bf16_t* P1, bf16_t* Y, float* scr  , const float lam,
                                       const float* gsub, char* lds) {
  const long tok0 = (long)b * SEQ + qb * 256;
  const float nsl2 = __uint_as_float(__builtin_amdgcn_readfirstlane(__float_as_uint(-__builtin_amdgcn_exp2f(-(float)(h + 1)) * LOG2E)));
  const bf16_t* Qp = hm(P1, 12 + h, b) + (long)qb * 256 * 128; const bf16_t* Kp = hm(P1, 20 + h, b);
  f32x16 o[4];
  attn_core<4, true, 0>(Qp, Kp, (int)(8 * HSTRIDE), 128, 128, 0.125f, nsl2, qb * 256, SEQ, lds, o);
  { int lane_ = threadIdx.x & 63; asm volatile("" : "+v"(lane_)); float* sp = scr + lane_;
#pragma unroll
  for (int d0 = 0; d0 < 4; ++d0)
#pragma unroll
    for (int r = 0; r < 16; ++r) sp[(d0 * 16 + r) * 64] = o[d0][r]; }
  attn_core<4, true, 4>(Qp, Kp, (int)(8 * HSTRIDE), 128, 128, 0.125f, nsl2, qb * 256, SEQ, lds, o);
  int tid = threadIdx.x; asm volatile("" : "+v"(tid));
  const int wid = tid >> 6, lane = tid & 63, r32 = lane & 31, hi = lane >> 5;
  { const float* sp = scr + lane;
#pragma unroll
  for (int d0 = 0; d0 < 4; ++d0)
#pragma unroll
    for (int r = 0; r < 16; ++r) o[d0][r] = sp[(d0 * 16 + r) * 64] - lam * o[d0][r]; }
  bf16_t* stg = (bf16_t*)(lds + ATT_STG_OFF + wid * STG_BYTES);
  const long tok = tok0 + wid * 32 + (lane >> 1); const int ch = (lane & 1) * 64;
  const bf16_t* gp = hm(P1, 44 + h, b) + (long)(qb * 256 + wid * 32 + (lane >> 1)) * 128 + ch; bf16_t* yp = Y + tok * 2048 + 1024 + h * 128 + ch; const float* gs = gsub + ch;
  bf16x8 gv[8]; f32x4v gsv[16];
  asm volatile("" : "+v"(gp));
#pragma unroll
  for (int i = 0; i < 8; ++i) gv[i] = *reinterpret_cast<const bf16x8*>(gp + i * 8);
  stage_o(o, stg, r32, hi);
#pragma unroll
  for (int i = 0; i < 16; ++i) gsv[i] = *reinterpret_cast<const f32x4v*>(gs + i * 4);
  bf16x8 ov[8]; float ss = 0.f;
#pragma unroll
  for (int i = 0; i < 8; ++i) { ov[i] = stage_rd(stg, lane, i);
#pragma unroll
    for (int e = 0; e < 8; ++e) { const float x = bfs(ov[i][e]); ss += x * x; } }
  ss += __uint_as_float(__builtin_amdgcn_update_dpp(0, __float_as_uint(ss), 0xB1, 0xf, 0xf, true));
  const float rinv = __builtin_amdgcn_rsqf(ss * (1.f / 128.f) + 1e-5f) * 0.8f;
#pragma unroll
  for (int i = 0; i < 8; ++i) { float v[8];
#pragma unroll
    for (int e = 0; e < 8; ++e) v[e] = bfs(ov[i][e]) * rinv * gsv[2 * i + (e >> 2)][e & 3] * silu(bfs(gv[i][e]));
    *reinterpret_cast<u32x4*>(yp + i * 8) = pack8(v); }
  asm volatile("s_waitcnt lgkmcnt(0)" ::: "memory");
}

constexpr int WG_TILE_REGION = 12 * 8192;
#define WBAR() asm volatile("s_waitcnt lgkmcnt(0)\n\ts_barrier" ::: "memory")
template <int R, bool FINAL>
__device__ __forceinline__ void win_seq(const int nu, const int bh0, const int bhstep, const int g, const bf16_t* P3, char* lds,
                                        bf16_t* Op, float* lsep, const bf16_t* O0, const float* lse0, const bf16_t* O1, const float* lse1, bf16_t* Y) {
  constexpr int NBLK = 2048 / R / 32;
  constexpr int NS = (R == 16) ? 8 : 12;
  const int wid = __builtin_amdgcn_readfirstlane(threadIdx.x >> 6);
  const int cls = (R == 1) ? 0 : (R == 4) ? (g >> 1) : (2 * g + (wid >> 2));
  const int n = (R == 1) ? (8 * g + wid) : (R == 4) ? ((g & 1) * 8 + wid) : (wid & 3);
  const int T0 = (R == 16) ? 0 : (((R == 1) ? 8 * g : (g & 1) * 8) - 2);
  float* wsf = (float*)(lds + WG_TILE_REGION) + wid * 64;
  bf16_t* stg = (bf16_t*)(lds + wid * STG_BYTES);
  const float C1 = 0.08838834764831845f * LOG2E;
#define LANEVALS int tid = threadIdx.x; asm volatile("" : "+v"(tid)); const int lane = tid & 63, r32 = lane & 31, hi = lane >> 5; \
    const int lr = tid >> 4, lc8 = (tid & 15) * 8; (void)lane; (void)r32; (void)hi; (void)lr; (void)lc8
#define SLOT_CLASS(s) ((R == 16) ? (2 * g + ((s) >> 2)) : cls)
#define SLOT_TILE(s)  ((R == 16) ? ((s) & 3) : (T0 + (s)))
#define SLOT_OK(s)    ((R == 16) ? true : (SLOT_TILE(s) >= 0 && SLOT_TILE(s) < NBLK))
#define LOAD_TILES(dst, colhead, b_, h_) LOAD_TILES_R(dst, colhead, b_, h_, 0, NS)
#define LOAD_TILES_R(dst, colhead, b_, h_, SLO, SHI) do { LANEVALS; const unsigned ldoff = (unsigned)(lr * R * 128 + lc8); const bf16_t* base_ = hm(P3, (colhead) + (h_), (b_)); \
    _Pragma("unroll") for (int s_ = (SLO); s_ < (SHI); ++s_) { int tl_ = SLOT_TILE(s_); tl_ = __builtin_amdgcn_readfirstlane(tl_ < 0 ? 0 : (tl_ > NBLK - 1 ? NBLK - 1 : tl_));     \
      const bf16_t* sb_ = base_ + (long)(tl_ * 32 * R + SLOT_CLASS(s_)) * 128; dst[s_] = *reinterpret_cast<const bf16x8*>(sb_ + ldoff); } } while (0)
#define LOAD_Q(b_, h_) do { LANEVALS; const unsigned qoff = (unsigned)(r32 * R * 128 + hi * 8); const bf16_t* qb_ = hm(P3, (h_), (b_)) + (long)(32 * n * R + cls) * 128; \
    _Pragma("unroll") for (int d0 = 0; d0 < 8; ++d0) qn[d0] = *reinterpret_cast<const bf16x8*>(qb_ + qoff + d0 * 16); } while (0)
  bf16x8 kst[NS], qn[8];
  LOAD_TILES(kst, 16, bh0 >> 4, bh0 & 15); LOAD_Q(bh0 >> 4, bh0 & 15);
  for (int u = 0; u < nu; ++u) {
    const int bh = bh0 + u * bhstep, b = bh >> 4, h = bh & 15;
    const float C2 = -__builtin_amdgcn_exp2f(-0.5f * (float)(h + 1)) * (float)R * LOG2E;
    WBAR();
    { LANEVALS; const int kst_off = KSWZ(lr, lc8 * 2);
#pragma unroll
    for (int s = 0; s < NS; ++s) *(bf16x8*)(lds + s * 8192 + kst_off) = kst[s]; }
    bf16x8 qr[8];
#pragma unroll
    for (int d0 = 0; d0 < 8; ++d0) qr[d0] = qn[d0];
    bf16x8 vst[NS];
    LOAD_TILES(vst, 32, b, h);
    WBAR();
    LANEVALS;
    const float fb0 = (float)(r32 + 64 - 4 * hi);
    f32x16 p[5];
#pragma unroll
    for (int j = 0; j < 5; ++j) {
      const int tile = n - 2 + j;
      if (tile >= 0 && tile < NBLK) {
        const char* Ks = lds + ((R == 16) ? ((wid >> 2) * 4 + tile) : (wid + j)) * 8192;
        f32x16 acc = f32x16{};
#pragma unroll
        for (int d0 = 0; d0 < 8; ++d0) { const bf16x8 b0 = *reinterpret_cast<const bf16x8*>(Ks + KSWZ(r32, (d0 * 16 + hi * 8) * 2));
          acc = __builtin_amdgcn_mfma_f32_32x32x16_bf16(b0, qr[d0], acc, 0, 0, 0); }
        float fb = fb0 - (float)(32 * j); asm volatile("" : "+v"(fb));
#pragma unroll
        for (int rr = 0; rr < 16; ++rr) { const float d = fabsf(fb - (float)((rr & 3) + 8 * (rr >> 2)));
          const float t = fmaf(d, C2, acc[rr] * C1); acc[rr] = (d <= 64.f) ? t : -INFINITY; }
        p[j] = acc;
      } else {
#pragma unroll
        for (int rr = 0; rr < 16; ++rr) p[j][rr] = -INFINITY;
      }
    }
    float mx = -INFINITY;
#pragma unroll
    for (int j = 0; j < 5; ++j)
#pragma unroll
      for (int rr = 0; rr < 16; ++rr) mx = fmaxf(mx, p[j][rr]);
    mx = swapmax(mx);
    float ls = 0.f;
#pragma unroll
    for (int j = 0; j < 5; ++j)
#pragma unroll
      for (int rr = 0; rr < 16; ++rr) { p[j][rr] = __builtin_amdgcn_exp2f(p[j][rr] - mx); ls += p[j][rr]; }
    ls = swapsum(ls);
    bf16x8 pa[5][2];
#pragma unroll
    for (int j = 0; j < 5; ++j) { PK4(p[j], 0, pa[j][0]); PK4(p[j], 8, pa[j][1]); }
    WBAR();
    { const int vst_off = v_st(lr, lc8);
#pragma unroll
    for (int s = 0; s < NS; ++s) *(bf16x8*)(lds + s * 8192 + vst_off) = vst[s]; }
    const int vb0 = (int)(uintptr_t)lds + v_rd_base(lane);
    if (!FINAL && u + 1 < nu) { const int nbh = bh + bhstep; LOAD_TILES_R(kst, 16, nbh >> 4, nbh & 15, 0, NS / 2); }
    WBAR();
    f32x16 o[4];
#pragma unroll
    for (int d = 0; d < 4; ++d) o[d] = f32x16{};
#pragma unroll
    for (int j = 0; j < 5; ++j) {
      const int tile = n - 2 + j;
      if (tile >= 0 && tile < NBLK) {
        const int vb = vb0 + ((R == 16) ? ((wid >> 2) * 4 + tile) : (wid + j)) * 8192;
        pv_one32<0>(o[0], vb, pa[j][0], pa[j][1]); pv_one32<1>(o[1], vb, pa[j][0], pa[j][1]); pv_one32<2>(o[2], vb, pa[j][0], pa[j][1]); pv_one32<3>(o[3], vb, pa[j][0], pa[j][1]);
      }
    }
    if (!FINAL && u + 1 < nu) { const int nbh = bh + bhstep; LOAD_TILES_R(kst, 16, nbh >> 4, nbh & 15, NS / 2, NS); LOAD_Q(nbh >> 4, nbh & 15); }
    const int row = lane >> 1, ch = (lane & 1) * 64;
    const int tseq = (32 * n + row) * R + cls; const long tok = (long)b * SEQ + tseq; const long hrow = ((long)(b * 16 + h) * 2048 + tseq);
    bf16x8 x0v[8], x1v[8], gtv[8]; float a0 = 0.f, a1 = 0.f;
    if constexpr (FINAL) {
      a0 = lse0[hrow]; a1 = lse1[hrow];
      const bf16_t* p0 = O0 + hrow * 128 + ch; const bf16_t* p1 = O1 + hrow * 128 + ch; const bf16_t* gp = hm(P3, 48 + h, b) + (long)tseq * 128 + ch;
#pragma unroll
      for (int i = 0; i < 8; ++i) { x0v[i] = *reinterpret_cast<const bf16x8*>(p0 + i * 8); x1v[i] = *reinterpret_cast<const bf16x8*>(p1 + i * 8); gtv[i] = *reinterpret_cast<const bf16x8*>(gp + i * 8); }
    }
    const float lse2 = mx + __builtin_amdgcn_logf(ls);
    if (hi == 0) { wsf[r32] = ls; wsf[32 + r32] = lse2; } asm volatile("s_waitcnt lgkmcnt(0)" ::: "memory");
#pragma unroll
    for (int rr = 0; rr < 16; ++rr) { const float rl = __builtin_amdgcn_rcpf(wsf[crow(rr, hi)]);
#pragma unroll
      for (int d = 0; d < 4; ++d) o[d][rr] *= rl; }
    const float mylse = wsf[32 + row];
    WBAR();
    stage_o(o, stg, r32, hi);
    if constexpr (!FINAL) {
      bf16_t* op = Op + hrow * 128 + ch;
#pragma unroll
      for (int i = 0; i < 8; ++i) *reinterpret_cast<bf16x8*>(op + i * 8) = stage_rd(stg, lane, i);
      if ((lane & 1) == 0) lsep[hrow] = mylse;
    } else {
      const float mxl = fmaxf(fmaxf(a0, a1), mylse);
      float w0 = __builtin_amdgcn_exp2f(a0 - mxl), w1 = __builtin_amdgcn_exp2f(a1 - mxl), w2 = __builtin_amdgcn_exp2f(mylse - mxl);
      const float rden = __builtin_amdgcn_rcpf(w0 + w1 + w2); w0 *= rden; w1 *= rden; w2 *= rden;
      bf16_t* yp = Y + tok * 2048 + h * 128 + ch;
#pragma unroll
      for (int i = 0; i < 8; ++i) { const bf16x8 ov = stage_rd(stg, lane, i); float v[8];
#pragma unroll
        for (int e = 0; e < 8; ++e) v[e] = (w0 * bfs(x0v[i][e]) + w1 * bfs(x1v[i][e]) + w2 * bfs(ov[e])) * silu(bfs(gtv[i][e]));
        *reinterpret_cast<u32x4*>(yp + i * 8) = pack8(v); }
      if (u + 1 < nu) { const int nbh = bh + bhstep; LOAD_TILES(kst, 16, nbh >> 4, nbh & 15); LOAD_Q(nbh >> 4, nbh & 15); }
    }
    asm volatile("s_waitcnt lgkmcnt(0)" ::: "memory");
  }
  WBAR();
#undef SLOT_CLASS
#undef SLOT_TILE
#undef SLOT_OK
#undef LOAD_TILES
#undef LOAD_TILES_R
#undef LANEVALS
#undef LOAD_Q
}
#undef PK4
#undef PKV
#undef KSWZ
#undef SBAR
}
#define LAS __attribute__((address_space(3)))
typedef unsigned short bf16;
typedef unsigned v4u __attribute__((ext_vector_type(4)));
typedef float f32x4 __attribute__((ext_vector_type(4)));
constexpr int NWAVES = 8;
constexpr int T = 32768, SEQ = 2048, DM = 2048, N1 = 6656, N3 = 8192;
constexpr float NORM_EPS = 1e-6f;
constexpr size_t MiB = 1u << 20;
constexpr size_t WS_CTL = 0, CTL_ZERO_BYTES = 1 * MiB;
constexpr size_t WS_W1 = 2 * MiB, WS_W2 = 28 * MiB, WS_W3 = 36 * MiB, WS_W4 = 68 * MiB;
constexpr size_t WS_U = 76 * MiB;
constexpr size_t WS_Y = 204 * MiB;
constexpr size_t WS_O2 = 332 * MiB;
constexpr size_t WS_P = 460 * MiB;
constexpr size_t WS_LSE = 980 * MiB;
constexpr size_t WS_END = 984 * MiB;
constexpr int LDS_BYTES = 147456;
static_assert(att::ATT_LDS_BYTES <= 131072 + 8192 && att::WG_TILE_REGION + 8 * 256 <= LDS_BYTES - 64 && att::ATT_LDS_BYTES <= LDS_BYTES - 64, "LDS map");

__device__ __forceinline__ unsigned f2bf(float f) { unsigned u = __builtin_bit_cast(unsigned, f); return (u + 0x7fffu + ((u >> 16) & 1u)) >> 16; }
__device__ __forceinline__ unsigned pk2(float lo, float hi) { return f2bf(lo) | (f2bf(hi) << 16); }
__device__ __forceinline__ float bf2f(unsigned short v) { return __uint_as_float(((unsigned)v) << 16); }
__device__ __forceinline__ float wave_sum(float v) {
#pragma unroll
    for (int o = 1; o < 64; o <<= 1) v += __shfl_xor(v, o);
    return v;
}
__device__ __forceinline__ void p0_transpose_item(const float* W, int K, int N, bf16* WT, LAS float* scr, int item, int lane) {
    const int nblk = N / 32, kb = item / nblk, nb = item % nblk, k0 = 64 * kb, n0 = 32 * nb;
#pragma unroll 8
    for (int i = 0; i < 32; ++i) { const int kk = 2 * i + (lane >> 5); scr[kk * 33 + (lane & 31)] = W[(size_t)(k0 + kk) * N + n0 + (lane & 31)]; }
    asm volatile("s_waitcnt lgkmcnt(0)" ::: "memory");
    const int c = lane & 7;
#pragma unroll
    for (int j = 0; j < 4; ++j) { const int n = (lane >> 3) + 8 * j; const LAS float* s = scr + (8 * c) * 33 + n;
        v4u o; o.x = pk2(s[0 * 33], s[1 * 33]); o.y = pk2(s[2 * 33], s[3 * 33]); o.z = pk2(s[4 * 33], s[5 * 33]); o.w = pk2(s[6 * 33], s[7 * 33]);
        *(v4u*)(WT + (size_t)(n0 + n) * K + k0 + 8 * c) = o; }
    asm volatile("s_waitcnt lgkmcnt(0)" ::: "memory");
}
__device__ __forceinline__ void rms_row_to_bf16(const float* xrow, const float* g, bf16* orow, int lane, float* rms_out) {
    const f32x4* xr = (const f32x4*)xrow + lane; const f32x4* gr = (const f32x4*)g + lane;
    f32x4 v[8]; float s = 0.f;
#pragma unroll
    for (int j = 0; j < 8; ++j) { v[j] = xr[64 * j]; s += (v[j].x * v[j].x + v[j].y * v[j].y) + (v[j].z * v[j].z + v[j].w * v[j].w); }
    const float rms = sqrtf(wave_sum(s) * (1.f / DM) + NORM_EPS); const float rstd = 1.f / rms;
    if (lane == 0) *rms_out = rms;
    unsigned long long* o8 = (unsigned long long*)orow + lane;
#pragma unroll
    for (int j = 0; j < 8; ++j) { const f32x4 gg = gr[64 * j];
        o8[64 * j] = (unsigned long long)pk2(v[j].x * rstd * gg.x, v[j].y * rstd * gg.y) | ((unsigned long long)pk2(v[j].z * rstd * gg.z, v[j].w * rstd * gg.w) << 32); }
}

#define RLX_AGENT __ATOMIC_RELAXED, __HIP_MEMORY_SCOPE_AGENT
#define XB_TMO      128
#define XB_XCNT(j)  (256  + 64 * (j))
#define XB_XSUB(j)  (1280 + 64 * (j))
#define XB_XGEN(j)  (2304 + 64 * (j))
#define XB_TOP      3328
#define XB_TOPGEN   3392
#define XCD_BAR_WORDS 3456
#define XB_SPIN_CAP (1u << 18)

__device__ __forceinline__ unsigned xb_ld(unsigned* p)              { return __hip_atomic_load(p, __ATOMIC_RELAXED, __HIP_MEMORY_SCOPE_AGENT); }
__device__ __forceinline__ unsigned xb_add(unsigned* p, unsigned v) { return __hip_atomic_fetch_add(p, v, __ATOMIC_RELAXED, __HIP_MEMORY_SCOPE_AGENT); }
__device__ __forceinline__ unsigned xb_xcc_id() { return (unsigned)__builtin_amdgcn_s_getreg((3 << 11) | 20) & 0xFu; }
#define XB_SPIN(cond, bar) do { unsigned _sp = 0; while (cond) { __builtin_amdgcn_s_sleep(1); \
    if ((++_sp & 255u) == 0u) { if (xb_ld(&(bar)[XB_TMO])) break; if (_sp > XB_SPIN_CAP) { atomicAdd(&(bar)[XB_TMO], 1u); break; } } } } while (0)

struct XcdBarrier {
    unsigned* bar; unsigned x;
    volatile LAS unsigned* st;
};

__device__ __forceinline__ XcdBarrier xcd_barrier_post(unsigned* bar, volatile LAS unsigned* st) {
    XcdBarrier b; b.bar = bar; b.x = xb_xcc_id(); b.st = st;
    if (threadIdx.x == 0) (void)xb_add(&bar[XB_XCNT(b.x)], 1u);
    return b;
}
__device__ __forceinline__ void xcd_barrier_complete(unsigned* bar, unsigned x, unsigned& nloc, unsigned& nx) {
    const unsigned G = gridDim.x * gridDim.y * gridDim.z;
    unsigned sum, cnt, mine, sp = 0u;
    for (;;) {
        sum = 0u; cnt = 0u; mine = 0u;
#pragma unroll
        for (unsigned j = 0; j < 16; ++j) { const unsigned c = xb_ld(&bar[XB_XCNT(j)]); sum += c; cnt += (c > 0u) ? 1u : 0u; mine = (j == x) ? c : mine; }
        if (sum == G) break;
        __builtin_amdgcn_s_sleep(1);
        if ((++sp & 255u) == 0u) { if (xb_ld(&bar[XB_TMO])) break; if (sp > XB_SPIN_CAP) { atomicAdd(&bar[XB_TMO], 1u); break; } }
    }
    nloc = mine > 0u ? mine : 1u; nx = cnt > 0u ? cnt : 1u;
}

__device__ __forceinline__ void xcd_barrier(const XcdBarrier& b) {
    asm volatile("s_waitcnt vmcnt(0)" ::: "memory");
    __syncthreads();
    if (threadIdx.x == 0) {
        unsigned* bar = b.bar;
        __builtin_amdgcn_s_waitcnt(0);
        unsigned nloc = b.st[0], nx = b.st[1];
        if (nloc == 0u) { xcd_barrier_complete(bar, b.x, nloc, nx); b.st[0] = nloc; b.st[1] = nx; }
        const unsigned old = xb_add(&bar[XB_XSUB(b.x)], 1u);
        const unsigned gen = old / nloc;
        if (old + 1u == (gen + 1u) * nloc) {
            __builtin_amdgcn_fence(__ATOMIC_RELEASE, "agent");
            asm volatile("s_waitcnt vmcnt(0)" ::: "memory");
            const unsigned og = xb_add(&bar[XB_TOP], 1u);
            const unsigned tg = og / nx;
            if (og + 1u == (tg + 1u) * nx) xb_add(&bar[XB_TOPGEN], 1u);
            else XB_SPIN(xb_ld(&bar[XB_TOPGEN]) == tg, bar);
            __builtin_amdgcn_fence(__ATOMIC_ACQUIRE, "agent");
            xb_add(&bar[XB_XGEN(b.x)], 1u);
            asm volatile("s_waitcnt vmcnt(0)" ::: "memory");
        } else {
            XB_SPIN(xb_ld(&bar[XB_XGEN(b.x)]) == gen, bar);
            __builtin_amdgcn_fence(__ATOMIC_ACQUIRE, "agent");
            asm volatile("s_waitcnt vmcnt(0)" ::: "memory");
        }
    }
    __syncthreads();
}
struct Args { const float* in[15]; float* out; unsigned char* ws; int ph_lo, ph_hi; };
constexpr int NPHASE = 10;
__global__ void __launch_bounds__(NWAVES * 64, 2) fwd_mega(Args args) {
    extern __shared__ __attribute__((aligned(16))) unsigned char lds[];
    cg::grid_group grid = cg::this_grid();
    const int wave = __builtin_amdgcn_readfirstlane(threadIdx.x >> 6);
#define LANE_INIT int tid = threadIdx.x; asm volatile("" : "+v"(tid)); const int lane = tid & 63; (void)lane
    const int G = gridDim.x; const int bx = blockIdx.x; const int vcu = (G % 8 == 0) ? (bx % 8) * (G / 8) + bx / 8 : bx;
    const int gw = vcu * NWAVES + wave, NGW = G * NWAVES;
    unsigned char* ws = args.ws;
    float* rowss1 = (float*)(ws + WS_CTL); float* rowss2 = (float*)(ws + WS_CTL + 131072);
    float* ropec = (float*)(ws + WS_CTL + 262144); float* ropes = ropec + 2048;
    float* rms0 = (float*)(ws + WS_CTL + 655360);
    bf16* W1t = (bf16*)(ws + WS_W1); bf16* W2t = (bf16*)(ws + WS_W2); bf16* W3t = (bf16*)(ws + WS_W3); bf16* W4t = (bf16*)(ws + WS_W4);
    bf16* U = (bf16*)(ws + WS_U); bf16* Y = (bf16*)(ws + WS_Y); bf16* P = (bf16*)(ws + WS_P);
    bf16* O2 = (bf16*)(ws + WS_O2); float* LSE = (float*)(ws + WS_LSE);
    const float* x = args.in[0]; float* out = args.out;
    const int lo = args.ph_lo, hi = args.ph_hi;
#ifndef PH_MASK
#define PH_MASK 0x3ff
#endif
#define IN(k) (((PH_MASK >> (k)) & 1) && lo <= (k) && (k) < hi)
    volatile LAS unsigned* bst = (volatile LAS unsigned*)((LAS unsigned char*)lds + LDS_BYTES - 64);
    if (threadIdx.x < 16) bst[threadIdx.x] = 0u;
    __syncthreads();
    XcdBarrier xbar = xcd_barrier_post((unsigned*)(ws + WS_CTL + 524288), bst);
#define SEAM(k) do { if (IN(k) && IN((k) + 1)) { if ((k) == 0) grid.sync(); else xcd_barrier(xbar); } } while (0)
    LAS unsigned char* ldsl = (LAS unsigned char*)lds;

    if (IN(0)) {
        LANE_INIT;
        LAS float* scr = (LAS float*)(ldsl + wave * 16384);
        constexpr int I1 = (DM / 64) * (N1 / 32), I2 = (DM / 64) * (DM / 32), I3 = (DM / 64) * (N3 / 32), I4 = I2;
        constexpr int NITEMS = I1 + I2 + I3 + I4;
        for (int it = gw; it < NITEMS; it += NGW) {
            int r = it;
            if (r < I1) { p0_transpose_item(args.in[2], DM, N1, W1t, scr, r, lane); continue; } r -= I1;
            if (r < I2) { p0_transpose_item(args.in[10], DM, DM, W2t, scr, r, lane); continue; } r -= I2;
            if (r < I3) { p0_transpose_item(args.in[12], DM, N3, W3t, scr, r, lane); continue; } r -= I3;
            p0_transpose_item(args.in[13], DM, DM, W4t, scr, r, lane);
        }
        for (int m = gw; m < T; m += NGW) rms_row_to_bf16(x + (size_t)m * DM, args.in[1], U + (size_t)m * DM, lane, rms0 + m);
        if (tid < 8 && bx * 8 + tid < 2048) { const int i = bx * 8 + tid; const int id = i >> 5, j = i & 31;
            const float invf = powf(10000.0f, -(float)j / 32.0f); const float ang = (float)id * invf; ropec[i] = cosf(ang); ropes[i] = sinf(ang);
            if (i < 128) ropec[4096 + i] = args.in[3][i]; }
    }
    SEAM(0);
    if (IN(1)) {
        pg8::Gemm g{U, W1t, T, N1, DM}; pg8::StaticOrder S; S.init(T, N1, G, bx);
        pg8::EpiBf16RS E{P, N1, nullptr, 0.f, 0.f};
        pg8::gemm_phase<pg8::EpiBf16RS, pg8::StaticOrder, true, true>(ldsl, g, S, E);
    }
    SEAM(1);
    if (IN(2)) {
        LANE_INIT;
        const float* gq = args.in[3]; const float* gk = args.in[4];
        typedef short bf16x8 __attribute__((ext_vector_type(8)));
        const int hs = lane >> 4, c = lane & 15, cs = c & 7, sec = c >> 3, j0 = (cs & 3) * 8;
        static_assert(T * 2 / 4 == 8 * 256 * NWAVES, "K norm/rope phase: 8 groups per wave on a 256-workgroup grid");
        bf16* pp[8]; bf16x8 vv[8];
#pragma unroll
        for (int k = 0; k < 8; ++k) { const int it = (gw + k * NGW) * 4 + hs; const int tok = it >> 1, hh = 8 + (it & 1);
            pp[k] = P + ((size_t)(hh * 16 + (tok >> 11)) * 2048 + (tok & 2047)) * 128 + c * 8; vv[k] = *(const bf16x8*)pp[k]; }
        const f32x4 g0 = *(const f32x4*)(gk + c * 8), g1 = *(const f32x4*)(gk + c * 8 + 4);
        const float gv[8] = {g0.x, g0.y, g0.z, g0.w, g1.x, g1.y, g1.z, g1.w};
#pragma unroll
        for (int k = 0; k < 8; ++k) {
            const int it = (gw + k * NGW) * 4 + hs; const int tok = it >> 1;
            const int s = tok & (SEQ - 1); const int id = sec ? (s & 63) : (s >> 6);
            const f32x4 c0 = *(const f32x4*)(ropec + id * 32 + j0), c1 = *(const f32x4*)(ropec + id * 32 + j0 + 4);
            const f32x4 s0 = *(const f32x4*)(ropes + id * 32 + j0), s1 = *(const f32x4*)(ropes + id * 32 + j0 + 4);
            float xv[8]; float ss = 0.f;
#pragma unroll
            for (int e = 0; e < 8; ++e) { xv[e] = bf2f((unsigned short)vv[k][e]); ss += xv[e] * xv[e]; }
            ss += __shfl_xor(ss, 1); ss += __shfl_xor(ss, 2); ss += __shfl_xor(ss, 4); ss += __shfl_xor(ss, 8);
            const float rinv = 1.f / sqrtf(ss * (1.f / 128.f) + NORM_EPS);
            const float cv[8] = {c0.x, c0.y, c0.z, c0.w, c1.x, c1.y, c1.z, c1.w};
            const float sv[8] = {s0.x, s0.y, s0.z, s0.w, s1.x, s1.y, s1.z, s1.w};
            float ov[8];
#pragma unroll
            for (int e = 0; e < 8; ++e) { xv[e] = xv[e] * rinv * gv[e]; }
#pragma unroll
            for (int e = 0; e < 8; ++e) { const float px = __shfl_xor(xv[e], 4); ov[e] = (cs < 4) ? (xv[e] * cv[e] - px * sv[e]) : (xv[e] * cv[e] + px * sv[e]); }
            v4u w; w.x = pk2(ov[0], ov[1]); w.y = pk2(ov[2], ov[3]); w.z = pk2(ov[4], ov[5]); w.w = pk2(ov[6], ov[7]);
            *(v4u*)pp[k] = w;
        }
    }
    SEAM(2);
    if (IN(3)) {
        float lam;
        { LANE_INIT; const float a = args.in[5][lane] * args.in[6][lane], c = args.in[7][lane] * args.in[8][lane];
          lam = expf(wave_sum(a)) - expf(wave_sum(c)) + 0.2f; lam = __uint_as_float(__builtin_amdgcn_readfirstlane(__float_as_uint(lam))); }
        float* scrB = (float*)(ws + WS_O2) + (size_t)(vcu * NWAVES + wave) * 4096;
        const int xq = vcu >> 5, lc = vcu & 31;
        for (int i = 0; i < 4; ++i) { const int ua = xq * 128 + i * 32 + lc; att::unit_A(ua >> 6, (ua >> 3) & 7, ua & 7, P, Y, (char*)lds, ropec); }
        for (int i = 0; i < 4; ++i) { const int ub = xq * 128 + i * 32 + lc; att::unit_B(ub >> 6, (ub >> 3) & 7, ub & 7, P, Y, scrB, lam, args.in[9], (char*)lds); }
        __syncthreads();
    }
    SEAM(3);
    if (IN(4)) {
        pg8::Gemm g{Y, W2t, T, DM, DM}; pg8::StaticOrder S; S.init(T, DM, G, bx);
        pg8::EpiResidA E{U, args.in[1], rms0, args.in[11], rowss1, DM};
        pg8::gemm_phase<pg8::EpiResidA, pg8::StaticOrder, true, true>(ldsl, g, S, E);
    }
    SEAM(4);
    if (IN(5)) {
        pg8::Gemm g{U, W3t, T, N3, DM}; pg8::StaticOrder S; S.init(T, N3, G, bx);
        pg8::EpiBf16RS E{P, N3, rowss1, 1.f / DM, NORM_EPS};
        pg8::gemm_phase<pg8::EpiBf16RS, pg8::StaticOrder, true, true>(ldsl, g, S, E);
    }
    SEAM(5);
    if (IN(6)) {
        const int xq = vcu >> 5, lc = vcu & 31;
        if (((lc >> 3) & 1) == 0) att::win_seq<1, false>(16, xq * 32 + (lc >> 4), 2, lc & 7, P, (char*)lds, (bf16*)out, LSE, nullptr, nullptr, nullptr, nullptr, nullptr);
        else                      att::win_seq<4, false>(16, xq * 32 + (lc >> 4), 2, lc & 7, P, (char*)lds, O2, LSE + (size_t)T * 16, nullptr, nullptr, nullptr, nullptr, nullptr);
    }
    SEAM(6);
    if (IN(7)) {
        const int xq = vcu >> 5, lc = vcu & 31;
        att::win_seq<16, true>(8, xq * 32 + 31 - (lc >> 3), -4, lc & 7, P, (char*)lds, nullptr, nullptr, (const bf16*)out, LSE, O2, LSE + (size_t)T * 16, Y);
    }
    SEAM(7);
    if (IN(8)) {
        pg8::Gemm g{Y, W4t, T, DM, DM}; pg8::StaticOrder S; S.init(T, DM, G, bx);
        pg8::EpiResidB E{U, args.in[11], rowss2, DM};
        pg8::gemm_phase<pg8::EpiResidB, pg8::StaticOrder, true, true>(ldsl, g, S, E);
    }
    SEAM(8);
    if (IN(9)) {
        LANE_INIT;
        const f32x4* gr = (const f32x4*)args.in[14];
        for (int m = gw; m < T; m += NGW) {
            const float rs = 1.f / sqrtf(rowss2[m] * (1.f / DM) + NORM_EPS);
            const v4u* hp = (const v4u*)(U + (size_t)m * DM) + lane;
            f32x4* o = (f32x4*)(out + (size_t)m * DM);
#pragma unroll
            for (int j = 0; j < 4; ++j) { const v4u hw = hp[64 * j]; const int c4 = 2 * lane + 128 * j;
                const f32x4 g0 = gr[c4], g1 = gr[c4 + 1];
                f32x4 v0 = (f32x4){__uint_as_float(hw.x << 16), __uint_as_float(hw.x & 0xffff0000u), __uint_as_float(hw.y << 16), __uint_as_float(hw.y & 0xffff0000u)};
                f32x4 v1 = (f32x4){__uint_as_float(hw.z << 16), __uint_as_float(hw.z & 0xffff0000u), __uint_as_float(hw.w << 16), __uint_as_float(hw.w & 0xffff0000u)};
                o[c4] = v0 * rs * g0; o[c4 + 1] = v1 * rs * g1; }
        }
    }
#undef IN
#undef SEAM
}

#ifndef MK_N_LAUNCHES
#define MK_N_LAUNCHES 1
#endif
extern "C" void kernel_launch(void* const* d_in, const int* in_sizes, int n_in, void* d_out, int out_size, void* d_ws, size_t ws_size, hipStream_t stream) {
    static int grid = 0;
    if (grid == 0) {
        if (n_in != 15 || in_sizes[0] != T * DM || out_size != T * DM || ws_size < WS_END) {
            fprintf(stderr, "kernel_launch: unexpected shapes: n_in %d in0 %d out %d ws %zu (need %zu)\n", n_in, n_in > 0 ? in_sizes[0] : -1, out_size, ws_size, (size_t)WS_END); grid = -1; return; }
        int dev = 0, cus = 0, per_cu = 0;
        hipGetDevice(&dev); hipDeviceGetAttribute(&cus, hipDeviceAttributeMultiprocessorCount, dev);
        if (hipFuncSetAttribute((const void*)fwd_mega, hipFuncAttributeMaxDynamicSharedMemorySize, LDS_BYTES) != hipSuccess) { fprintf(stderr, "kernel_launch: hipFuncSetAttribute failed\n"); grid = -1; return; }
        if (hipOccupancyMaxActiveBlocksPerMultiprocessor(&per_cu, (const void*)fwd_mega, NWAVES * 64, LDS_BYTES) != hipSuccess || per_cu < 1) { fprintf(stderr, "kernel_launch: occupancy query says %d\n", per_cu); per_cu = 1; }
        (void)hipGetLastError();
        grid = 256;
        if (cus < 256) { fprintf(stderr, "kernel_launch: %d CUs < 256: cannot co-schedule the grid\n", cus); grid = -1; return; }
        if (grid != 256) fprintf(stderr, "kernel_launch: note: %d CUs (phase schedules assume 256)\n", grid);
    }
    if (grid < 0) return;
    hipMemsetAsync((char*)d_ws + WS_CTL, 0, CTL_ZERO_BYTES, stream);
    Args a{};
    for (int i = 0; i < 15; ++i) a.in[i] = (const float*)d_in[i];
    a.out = (float*)d_out; a.ws = (unsigned char*)d_ws;
#if MK_N_LAUNCHES == 1
    a.ph_lo = 0; a.ph_hi = NPHASE;
    void* kargs[] = {&a};
    hipError_t e = hipLaunchCooperativeKernel((const void*)fwd_mega, dim3(grid), dim3(NWAVES * 64), kargs, LDS_BYTES, stream);
    if (e != hipSuccess) fprintf(stderr, "kernel_launch: cooperative launch failed: %s (grid %d)\n", hipGetErrorString(e), grid);
#else
    for (int p = 0; p < NPHASE; ++p) { a.ph_lo = p; a.ph_hi = p + 1; hipLaunchKernelGGL(fwd_mega, dim3(grid), dim3(NWAVES * 64), LDS_BYTES, stream, a); }
#endif
}
```
